# Optimizing an MI355X kernel written in HIP

```python
import jax, jax.numpy as jnp
from jax import lax
import numpy as np

D_MODEL = 2048
BATCH = 1
SEQ = 16384
DEPTH = 2

ATTN_WIDTH = D_MODEL // 2
RET_WIDTH = D_MODEL - ATTN_WIDTH
MIX_WIDTH = ATTN_WIDTH + RET_WIDTH
ATTN_HEAD_DIM = 64
N_ATTN_HEADS = ATTN_WIDTH // ATTN_HEAD_DIM
N_KV_HEADS = N_ATTN_HEADS // 8
WINDOW = 128
ATTN_BLOCK = 128
RET_QK_DIM = 256
RET_V_DIM = 256
N_RET_HEADS = RET_WIDTH // RET_V_DIM
RET_CHUNK = 128
D_FF = 5632
N_SUBLAYERS = 3
N_MOD = 3
NORM_EPS = 1e-6
GN_EPS = 1e-5

IN_SIZES = [
    N_ATTN_HEADS * ATTN_HEAD_DIM,
    N_KV_HEADS * ATTN_HEAD_DIM,
    N_KV_HEADS * ATTN_HEAD_DIM,
    N_RET_HEADS * RET_QK_DIM,
    N_RET_HEADS * RET_QK_DIM,
    N_RET_HEADS * RET_V_DIM,
    N_RET_HEADS * RET_V_DIM,
]
IN_WIDTH = int(sum(IN_SIZES))
IN_OFFSETS = [int(o) for o in np.cumsum(IN_SIZES)[:-1]]

kernel_name = "hymba_swa_sink_retention_macaron"


def rms_norm(x, gain):
    x32 = x.astype(jnp.float32)
    y = x32 * lax.rsqrt(jnp.mean(x32 * x32, axis=-1, keepdims=True) + NORM_EPS)
    return (y * gain.astype(jnp.float32)).astype(x.dtype)


def modulate(h, shift, scale):
    return h * (1.0 + scale[:, None, :]) + shift[:, None, :]


def swiglu(h, w_gate, w_up, w_down):
    return (jax.nn.silu(h @ w_gate) * (h @ w_up)) @ w_down


def alibi_slopes(n_heads):
    return jnp.asarray(2.0 ** (-8.0 * (np.arange(n_heads) + 1) / n_heads), dtype=jnp.float32)


def sliding_window_attention(q, k, v, sinks):
    B, S, H, dh = q.shape
    W = ATTN_BLOCK
    nb = S // W
    G = H // N_KV_HEADS
    f32 = jnp.float32
    qb = q.astype(f32).reshape(B, nb, W, N_KV_HEADS, G, dh)
    kb = k.astype(f32).reshape(B, nb, W, N_KV_HEADS, dh)
    vb = v.astype(f32).reshape(B, nb, W, N_KV_HEADS, dh)
    prev = lambda t: jnp.concatenate([jnp.zeros_like(t[:, :1]), t[:, :-1]], axis=1)
    keys = jnp.concatenate([prev(kb), kb], axis=2)
    vals = jnp.concatenate([prev(vb), vb], axis=2)
    scores = jnp.einsum('bnqkgd,bnskd->bnkgqs', qb, keys) * (dh ** -0.5)
    qi = jnp.arange(W)[:, None]
    kj = jnp.arange(2 * W)[None, :]
    dist = qi + W - kj
    key_pos = jnp.arange(nb)[:, None, None] * W + kj - W
    valid = (dist >= 0) & (dist < WINDOW) & (key_pos >= 0)
    slopes = alibi_slopes(H).reshape(N_KV_HEADS, G)[:, :, None, None]
    scores = scores - slopes * dist.astype(f32)
    scores = jnp.where(valid[None, :, None, None], scores, -jnp.inf)
    sink = sinks.astype(f32).reshape(N_KV_HEADS, G)[:, :, None, None]
    m = jnp.maximum(jnp.max(scores, axis=-1, keepdims=True), sink)
    p = jnp.exp(scores - m)
    denom = jnp.sum(p, axis=-1, keepdims=True) + jnp.exp(sink - m)
    out = jnp.einsum('bnkgqs,bnskd->bnqkgd', p / denom, vals)
    return out.reshape(B, S, H * dh)


def retention(q, k, v):
    B, S, H, dk = q.shape
    dv = v.shape[-1]
    C = RET_CHUNK
    nc = S // C
    f32 = jnp.float32
    log_gamma = jnp.log(1.0 - 2.0 ** (-5.0 - jnp.arange(H, dtype=f32)))
    qc = q.astype(f32).reshape(B, nc, C, H, dk)
    kc = k.astype(f32).reshape(B, nc, C, H, dk) * (dk ** -0.5)
    vc = v.astype(f32).reshape(B, nc, C, H, dv)
    idx = jnp.arange(C, dtype=f32)
    rel = idx[:, None] - idx[None, :]
    decay_intra = jnp.where(rel >= 0, jnp.exp(log_gamma[:, None, None] * jnp.maximum(rel, 0.0)), 0.0)
    scores = jnp.einsum('bnihd,bnjhd->bnhij', qc, kc) * decay_intra
    inner = jnp.einsum('bnhij,bnjhe->bnihe', scores, vc)
    zeta = jnp.exp(log_gamma[:, None] * (C - 1.0 - idx)[None, :])
    kz = kc * zeta.T[None, None, :, :, None]
    kv = jnp.einsum('bnjhd,bnjhe->nbhde', kz, vc)
    chunk_decay = jnp.exp(log_gamma * C)[None, :, None, None]

    def step(state, kv_n):
        return chunk_decay * state + kv_n, state

    _, states = lax.scan(step, jnp.zeros((B, H, dk, dv), f32), kv)
    xi = jnp.exp(log_gamma[:, None] * (idx + 1.0)[None, :])
    cross = jnp.einsum('bnihd,nbhde->bnihe', qc, states) * xi.T[None, None, :, :, None]
    out = inner + cross
    mu = jnp.mean(out, axis=-1, keepdims=True)
    var = jnp.mean(jnp.square(out - mu), axis=-1, keepdims=True)
    out = (out - mu) * lax.rsqrt(var + GN_EPS)
    return out.reshape(B, S, H, dv)


def token_mixing(h, w_in, w_out, sinks):
    B, S, _ = h.shape
    proj = h @ w_in
    q_a, k_a, v_a, q_r, k_r, v_r, g_r = jnp.split(proj, IN_OFFSETS, axis=-1)
    y_a = sliding_window_attention(
        q_a.reshape(B, S, N_ATTN_HEADS, ATTN_HEAD_DIM),
        k_a.reshape(B, S, N_KV_HEADS, ATTN_HEAD_DIM),
        v_a.reshape(B, S, N_KV_HEADS, ATTN_HEAD_DIM),
        sinks).astype(h.dtype)
    y_r = retention(
        q_r.reshape(B, S, N_RET_HEADS, RET_QK_DIM),
        k_r.reshape(B, S, N_RET_HEADS, RET_QK_DIM),
        v_r.reshape(B, S, N_RET_HEADS, RET_V_DIM)).reshape(B, S, RET_WIDTH)
    y_r = (jax.nn.silu(g_r.astype(jnp.float32)) * y_r).astype(h.dtype)
    return jnp.concatenate([y_a, y_r], axis=-1) @ w_out


def sublayer(x, fn, g_pre, g_post, shift, scale, gate, res_weight):
    h = modulate(rms_norm(x, g_pre), shift, scale)
    return x + res_weight * gate[:, None, :] * rms_norm(fn(h), g_post)


def setup_inputs(seed: int = 0) -> dict:
    key = jax.random.key(seed)
    ks = jax.random.split(key, 16)
    f32 = jnp.float32
    n = lambda k, shape, s: jax.random.normal(k, shape, f32) * s
    D, F = D_MODEL, D_FF
    return {
        "x": n(ks[0], (BATCH, SEQ, D), 1.0),
        "c": n(ks[1], (BATCH, D), 1.0),
        "w_ada": n(ks[2], (DEPTH, D, N_SUBLAYERS * N_MOD * D), 0.5 * D ** -0.5),
        "b_ada": n(ks[3], (DEPTH, N_SUBLAYERS * N_MOD * D), 0.01),
        "norm_pre": 1.0 + n(ks[4], (DEPTH, N_SUBLAYERS, D), 0.05),
        "norm_post": 1.0 + n(ks[5], (DEPTH, N_SUBLAYERS, D), 0.05),
        "ffn1_gate": n(ks[6], (DEPTH, D, F), D ** -0.5),
        "ffn1_up": n(ks[7], (DEPTH, D, F), D ** -0.5),
        "ffn1_down": n(ks[8], (DEPTH, F, D), F ** -0.5),
        "w_in": n(ks[9], (DEPTH, D, IN_WIDTH), D ** -0.5),
        "w_out": n(ks[10], (DEPTH, MIX_WIDTH, D), MIX_WIDTH ** -0.5),
        "attn_sinks": n(ks[11], (DEPTH, N_ATTN_HEADS), 0.5),
        "ffn2_gate": n(ks[12], (DEPTH, D, F), D ** -0.5),
        "ffn2_up": n(ks[13], (DEPTH, D, F), D ** -0.5),
        "ffn2_down": n(ks[14], (DEPTH, F, D), F ** -0.5),
    }


def reference(x, c, w_ada, b_ada, norm_pre, norm_post, ffn1_gate, ffn1_up, ffn1_down,
              w_in, w_out, attn_sinks, ffn2_gate, ffn2_up, ffn2_down):
    B = x.shape[0]
    c_act = jax.nn.silu(c)
    for l in range(DEPTH):
        mods = (c_act @ w_ada[l] + b_ada[l]).reshape(B, N_SUBLAYERS, N_MOD, D_MODEL)
        x = sublayer(x, lambda h: swiglu(h, ffn1_gate[l], ffn1_up[l], ffn1_down[l]),
                     norm_pre[l, 0], norm_post[l, 0],
                     mods[:, 0, 0], mods[:, 0, 1], mods[:, 0, 2], 0.5)
        x = sublayer(x, lambda h: token_mixing(h, w_in[l], w_out[l], attn_sinks[l]),
                     norm_pre[l, 1], norm_post[l, 1],
                     mods[:, 1, 0], mods[:, 1, 1], mods[:, 1, 2], 1.0)
        x = sublayer(x, lambda h: swiglu(h, ffn2_gate[l], ffn2_up[l], ffn2_down[l]),
                     norm_pre[l, 2], norm_post[l, 2],
                     mods[:, 2, 0], mods[:, 2, 1], mods[:, 2, 2], 0.5)
    return x
```

```cpp
#include <hip/hip_runtime.h>
#include <cstdio>
#include <cstdint>
namespace pg8 {
#define PG8_LAS __attribute__((address_space(3)))
typedef unsigned short bf16_t;
typedef short bf16x8 __attribute__((ext_vector_type(8)));
typedef float f32x4 __attribute__((ext_vector_type(4)));
typedef unsigned u32x4 __attribute__((ext_vector_type(4)));
constexpr int BM = 256, BK = 64, HALF = 128, HTB = HALF * BK * 2  , STAGE_BYTES = 8 * HTB, NXCD = 8, WGM = 8;

__host__ __device__ __forceinline__ int lds_byte(int r, int c) { const int st = (r >> 4) * 2 + (c >> 5), rr = r & 15, cc = c & 31, ob = rr * 64 + cc * 2; return st * 1024 + (ob ^ (((ob >> 9) & 1) << 5)); }
__host__ __device__ __forceinline__ void stage_rc(int b, int& R, int& C) { const int st = b / 1024, sb = b % 1024, swz = sb ^ (((sb >> 9) & 1) << 5); R = (st >> 1) * 16 + swz / 64; C = (st & 1) * 32 + (swz % 64) / 2; }
__host__ __device__ __forceinline__ int perm32(int rho) { const int n = rho >> 4, i = rho & 15; return 8 * (i >> 2) + 4 * n + (i & 3); }

struct Unit { int pm, pn; };
struct Gemm { const bf16_t* A; const bf16_t* Bt; int M, N, K; };

struct StaticOrder {
    int nM, nN, nwg, G, c;
    __host__ __device__ void init(int M, int N, int G_, int c_) { nM = M / BM; nN = N / BM; nwg = nM * nN; G = G_; c = c_; }
    __host__ __device__ bool next(int i, Unit& u) const {
        const long L = (long)i * G + c; if (L >= nwg) return false;
        int wgid = (int)L; { const int q = nwg / NXCD, r = nwg % NXCD, xcd = wgid % NXCD, off = wgid / NXCD; wgid = (xcd < r ? xcd * (q + 1) : r * (q + 1) + (xcd - r) * q) + off; }
        const int nig = WGM * nN, gid = wgid / nig, fm = gid * WGM, gsz = (nM - fm) < WGM ? (nM - fm) : WGM;
        u.pm = fm + ((wgid % nig) % gsz); u.pn = (wgid % nig) / gsz; return true;
    }
    __device__ __forceinline__ void a_ready(const Unit&) const {}
    __device__ __forceinline__ void done(const Unit&) const {}
};

__device__ __forceinline__ unsigned cvt_pk_bf16(float lo, float hi) { unsigned r; asm volatile("v_cvt_pk_bf16_f32 %0, %1, %2" : "=v"(r) : "v"(lo), "v"(hi)); return r; }
struct EpiBf16 {
    static constexpr bool PERM = true, AFTER_DRAIN = false;
    bf16_t* O; int ldc;
    __device__ __forceinline__ void operator()(const f32x4 (&acc)[2][2][4][2], const Unit& u, int wr, int wc, int fr, int fq) const {
        const int row0 = u.pm * BM + wr * 64 + fr; const int col0 = u.pn * BM + wc * 32 + 8 * fq;
#pragma unroll
        for (int ai = 0; ai < 2; ++ai)
#pragma unroll
            for (int m = 0; m < 4; ++m) { bf16_t* rowp = O + (size_t)(row0 + ai * HALF + m * 16) * ldc + col0;
#pragma unroll
                for (int bj = 0; bj < 2; ++bj) { const f32x4 v0 = acc[ai][bj][m][0], v1 = acc[ai][bj][m][1];
                    u32x4 w; w.x = cvt_pk_bf16(v0[0], v0[1]); w.y = cvt_pk_bf16(v0[2], v0[3]); w.z = cvt_pk_bf16(v1[0], v1[1]); w.w = cvt_pk_bf16(v1[2], v1[3]);
                    *(u32x4*)(rowp + bj * HALF) = w; } }
    }
};
__device__ __forceinline__ float silu_mul(float g, float u) { return g * u * __builtin_amdgcn_rcpf(1.0f + __builtin_amdgcn_exp2f(-1.4426950408889634f * g)); }
struct EpiSwiGLU {
    static constexpr bool PERM = true, AFTER_DRAIN = false;
    bf16_t* O; int ldc;
    __device__ __forceinline__ void operator()(const f32x4 (&acc)[2][2][4][2], const Unit& u, int wr, int wc, int fr, int fq) const {
        const int row0 = u.pm * BM + wr * 64 + fr; const int col0 = u.pn * HALF + wc * 32 + 8 * fq;
#pragma unroll
        for (int ai = 0; ai < 2; ++ai)
#pragma unroll
            for (int m = 0; m < 4; ++m) { bf16_t* rowp = O + (size_t)(row0 + ai * HALF + m * 16) * ldc + col0;
                const f32x4 g0 = acc[ai][0][m][0], g1 = acc[ai][0][m][1], u0 = acc[ai][1][m][0], u1 = acc[ai][1][m][1];
                u32x4 w; w.x = cvt_pk_bf16(silu_mul(g0[0], u0[0]), silu_mul(g0[1], u0[1])); w.y = cvt_pk_bf16(silu_mul(g0[2], u0[2]), silu_mul(g0[3], u0[3]));
                w.z = cvt_pk_bf16(silu_mul(g1[0], u1[0]), silu_mul(g1[1], u1[1])); w.w = cvt_pk_bf16(silu_mul(g1[2], u1[2]), silu_mul(g1[3], u1[3]));
                *(u32x4*)rowp = w; }
    }
};

template <class Epi, class Sched, bool ALIGN_EPI = false, bool SP2 = false>
__device__ __forceinline__ void gemm_phase(PG8_LAS unsigned char* lds, const Gemm g, const Sched& S, const Epi& E, const int tid) {
    const int wid = __builtin_amdgcn_readfirstlane(tid >> 6), lane = tid & 63, wr = wid >> 2, wc = wid & 3, fr = lane & 15, fq = lane >> 4;
    const int K = g.K, nt = K / BK;
    unsigned voffA[2], voffB[2];
#pragma unroll
    for (int i = 0; i < 2; ++i) { int R, C; stage_rc(tid * 16 + i * 8192, R, C); const int Rb = Epi::PERM ? ((R & ~31) + perm32(R & 31)) : R;
        voffA[i] = (unsigned)(R * K + C) * 2u; voffB[i] = (unsigned)(Rb * K + C) * 2u; }
    const size_t kstep = (size_t)(BK * 2);
    const size_t hstep = (size_t)HALF * K * 2;
    const size_t tstep = 2 * hstep;
    const unsigned ldsw = (unsigned)wid * 1024u;
    const int aoff = lds_byte(wr * 64 + fr, fq * 8), boff = lds_byte(wc * 32 + fr, fq * 8);
#define PG8_SA(b, h) (((b) * 2 + (h)) * HTB)
#define PG8_SB(b, h) ((4 + (b) * 2 + (h)) * HTB)
#define PG8_STAGE(bufoff, gbase, voff) do { _Pragma("unroll") for (int _i = 0; _i < 2; ++_i) \
        __builtin_amdgcn_global_load_lds((const unsigned*)((const char*)(gbase) + (voff)[_i]), (PG8_LAS unsigned*)(lds + (bufoff) + ldsw + _i * 8192), 16, 0, 0); } while (0)
#define PG8_LDA(dst, b, h) do { _Pragma("unroll") for (int m = 0; m < 4; ++m) _Pragma("unroll") for (int k = 0; k < 2; ++k) dst[m][k] = *(const PG8_LAS bf16x8*)(lds + PG8_SA(b, h) + aoff + m * 2048 + k * 1024); } while (0)
#define PG8_LDB(dst, b, h) do { _Pragma("unroll") for (int n = 0; n < 2; ++n) _Pragma("unroll") for (int k = 0; k < 2; ++k) dst[n][k] = *(const PG8_LAS bf16x8*)(lds + PG8_SB(b, h) + boff + n * 2048 + k * 1024); } while (0)
#define PG8_MMA(ai, bj, At, Bt) do { __builtin_amdgcn_s_setprio(1); _Pragma("unroll") for (int m = 0; m < 4; ++m) _Pragma("unroll") for (int n = 0; n < 2; ++n) _Pragma("unroll") for (int k = 0; k < 2; ++k) \
        acc[ai][bj][m][n] = __builtin_amdgcn_mfma_f32_16x16x32_bf16(Bt[n][k], At[m][k], acc[ai][bj][m][n], 0, 0, 0); __builtin_amdgcn_s_setprio(0); } while (0)
#define PG8_WAIT_V(n) asm volatile("s_waitcnt vmcnt(" #n ")" ::: "memory")
#define PG8_WAIT_L(n) asm volatile("s_waitcnt lgkmcnt(" #n ")" ::: "memory")
#define PG8_BAR __builtin_amdgcn_s_barrier()
#define PG8_SCHED __builtin_amdgcn_sched_barrier(0)
    Unit cur, nxt; int ui = 0;
    if (!S.next(0, cur)) return;
    f32x4 acc[2][2][4][2];
#pragma unroll
    for (int a = 0; a < 2; ++a)
#pragma unroll
        for (int b = 0; b < 2; ++b)
#pragma unroll
            for (int m = 0; m < 4; ++m)
#pragma unroll
                for (int n = 0; n < 2; ++n) acc[a][b][m][n] = (f32x4){0.f, 0.f, 0.f, 0.f};
    bf16x8 At[4][2], B0[2][2], B1[2][2];
    const char* cA = (const char*)g.A + (size_t)cur.pm * tstep; const char* cB = (const char*)g.Bt + (size_t)cur.pn * tstep;
    S.a_ready(cur);
    if constexpr (SP2) {
        PG8_STAGE(PG8_SB(0, 0), cB, voffB); PG8_STAGE(PG8_SB(0, 1), cB + hstep, voffB); PG8_STAGE(PG8_SA(0, 0), cA, voffA); PG8_STAGE(PG8_SA(0, 1), cA + hstep, voffA);
        if (wr == 1) PG8_BAR;
        PG8_WAIT_V(2); PG8_BAR;
        PG8_STAGE(PG8_SB(1, 0), cB + kstep, voffB); PG8_STAGE(PG8_SA(1, 0), cA + kstep, voffA); PG8_STAGE(PG8_SB(1, 1), cB + hstep + kstep, voffB);
        PG8_WAIT_V(6); PG8_BAR;
    } else {
        PG8_STAGE(PG8_SB(0, 0), cB, voffB); PG8_STAGE(PG8_SA(0, 0), cA, voffA); PG8_STAGE(PG8_SB(0, 1), cB + hstep, voffB); PG8_STAGE(PG8_SA(0, 1), cA + hstep, voffA);
        if (wr == 1) PG8_BAR;
        PG8_WAIT_V(4); PG8_BAR;
        PG8_STAGE(PG8_SB(1, 0), cB + kstep, voffB); PG8_STAGE(PG8_SA(1, 0), cA + kstep, voffA); PG8_STAGE(PG8_SB(1, 1), cB + hstep + kstep, voffB);
        PG8_WAIT_V(6); PG8_BAR;
    }
    for (;;) {
        const bool has_next = S.next(ui + 1, nxt);
        const char* nA = has_next ? (const char*)g.A + (size_t)nxt.pm * tstep : cA; const char* nB = has_next ? (const char*)g.Bt + (size_t)nxt.pn * tstep : cB;
        for (int t = 0; t < nt; t += 2) {
            const bool last = (t == nt - 2);
            const char* a1 = cA + (size_t)(t + 1) * kstep;
            const char* a2 = last ? nA : cA + (size_t)(t + 2) * kstep; const char* b2 = last ? nB : cB + (size_t)(t + 2) * kstep;
            const char* a3 = a2 + kstep; const char* b3 = b2 + kstep;
            if (last && has_next) S.a_ready(nxt);
            if constexpr (SP2) {
            PG8_LDB(B0, 0, 0); PG8_LDB(B1, 0, 1); PG8_SCHED; PG8_LDA(At, 0, 0); PG8_STAGE(PG8_SA(1, 1), a1 + hstep, voffA);
            PG8_WAIT_V(8); PG8_WAIT_L(0); PG8_BAR; PG8_MMA(0, 0, At, B0); PG8_MMA(0, 1, At, B1); PG8_BAR; PG8_SCHED;
            PG8_LDA(At, 0, 1); PG8_STAGE(PG8_SB(0, 0), b2, voffB); PG8_STAGE(PG8_SB(0, 1), b2 + hstep, voffB); PG8_STAGE(PG8_SA(0, 0), a2, voffA);
            PG8_WAIT_V(8); PG8_WAIT_L(0); PG8_BAR; PG8_MMA(1, 0, At, B0); PG8_MMA(1, 1, At, B1); PG8_BAR; PG8_SCHED;
            PG8_LDB(B0, 1, 0); PG8_LDB(B1, 1, 1); PG8_SCHED; PG8_LDA(At, 1, 0); PG8_STAGE(PG8_SA(0, 1), a2 + hstep, voffA);
            PG8_WAIT_V(8); PG8_WAIT_L(0); PG8_BAR; PG8_MMA(0, 0, At, B0); PG8_MMA(0, 1, At, B1); PG8_BAR; PG8_SCHED;
            PG8_LDA(At, 1, 1); PG8_STAGE(PG8_SB(1, 0), b3, voffB); PG8_STAGE(PG8_SB(1, 1), b3 + hstep, voffB); PG8_STAGE(PG8_SA(1, 0), a3, voffA);
            PG8_WAIT_V(8); PG8_WAIT_L(0); PG8_BAR; PG8_MMA(1, 0, At, B0); PG8_MMA(1, 1, At, B1); PG8_BAR; PG8_SCHED;
            } else {
            PG8_LDB(B0, 0, 0); PG8_SCHED; PG8_LDA(At, 0, 0); PG8_STAGE(PG8_SA(1, 1), a1 + hstep, voffA);
            PG8_WAIT_L(8); PG8_BAR; PG8_WAIT_L(0); PG8_MMA(0, 0, At, B0); PG8_BAR; PG8_SCHED;
            PG8_LDB(B1, 0, 1); PG8_STAGE(PG8_SB(0, 0), b2, voffB);
            PG8_BAR; PG8_WAIT_L(0); PG8_MMA(0, 1, At, B1); PG8_BAR;
            PG8_LDA(At, 0, 1); PG8_STAGE(PG8_SA(0, 0), a2, voffA);
            PG8_BAR; PG8_WAIT_L(0); PG8_MMA(1, 0, At, B0); PG8_BAR; PG8_SCHED;
            PG8_STAGE(PG8_SB(0, 1), b2 + hstep, voffB);
            PG8_WAIT_V(6); PG8_BAR; PG8_MMA(1, 1, At, B1); PG8_BAR;
            PG8_LDB(B0, 1, 0); PG8_SCHED; PG8_LDA(At, 1, 0); PG8_STAGE(PG8_SA(0, 1), a2 + hstep, voffA);
            PG8_WAIT_L(8); PG8_BAR; PG8_WAIT_L(0); PG8_MMA(0, 0, At, B0); PG8_BAR; PG8_SCHED;
            PG8_LDB(B1, 1, 1); PG8_STAGE(PG8_SB(1, 0), b3, voffB);
            PG8_BAR; PG8_WAIT_L(0); PG8_MMA(0, 1, At, B1); PG8_BAR;
            PG8_LDA(At, 1, 1); PG8_STAGE(PG8_SA(1, 0), a3, voffA);
            PG8_BAR; PG8_WAIT_L(0); PG8_MMA(1, 0, At, B0); PG8_BAR; PG8_SCHED;
            PG8_STAGE(PG8_SB(1, 1), b3 + hstep, voffB);
            PG8_WAIT_V(6); PG8_BAR; PG8_MMA(1, 1, At, B1); PG8_BAR;
            }
        }
        if constexpr (ALIGN_EPI) { if (wr == 0) PG8_BAR; }
        if constexpr (!Epi::AFTER_DRAIN) { E(acc, cur, wr, wc, fr, fq); S.done(cur); }
        if (!has_next) break;
#pragma unroll
        for (int a = 0; a < 2; ++a)
#pragma unroll
            for (int b = 0; b < 2; ++b)
#pragma unroll
                for (int m = 0; m < 4; ++m)
#pragma unroll
                    for (int n = 0; n < 2; ++n) acc[a][b][m][n] = (f32x4){0.f, 0.f, 0.f, 0.f};
        cur = nxt; cA = nA; cB = nB; ++ui;
        if constexpr (ALIGN_EPI) { if (wr == 1) PG8_BAR; }
    }
    PG8_WAIT_V(0);
    if constexpr (!ALIGN_EPI) { if (wr == 0) PG8_BAR; }
    PG8_BAR;
    if constexpr (Epi::AFTER_DRAIN) { E.fused(acc, cur, wr, wc, fr, fq, lds, wid, lane); S.done(cur); }
#undef PG8_SA
#undef PG8_SB
#undef PG8_STAGE
#undef PG8_LDA
#undef PG8_LDB
#undef PG8_MMA
#undef PG8_WAIT_V
#undef PG8_WAIT_L
#undef PG8_BAR
#undef PG8_SCHED
}
}
#ifndef PG8_SP2
#define PG8_SP2 true
#endif
#ifndef PG8_ALIGN
#define PG8_ALIGN true
#endif
constexpr int NWAVES = 8;
constexpr int M = 16384, D = 2048, FF = 5632, INW = 5376, DEPTH = 2;
constexpr int OFF_QA = 0, OFF_KA = 1024, OFF_VA = 1152, OFF_QR = 1280, OFF_KR = 2304, OFF_VR = 3328, OFF_GR = 4352;
constexpr int NADA = 9 * D;
constexpr float NORM_EPS = 1e-6f, GN_EPS = 1e-5f;
#ifndef MK_PER_PHASE
#define MK_PER_PHASE 0
#endif
#ifndef SIMPLE_MIX
#define SIMPLE_MIX 1
#endif
constexpr int N_PHASES = 3 + 12 * DEPTH;

constexpr size_t MiB = 1u << 20;
constexpr size_t WS_CTL = 0, CTL_ZERO_BYTES = 1 * MiB;
constexpr size_t WS_MODP = 1 * MiB;
constexpr size_t WS_MODC = 4 * MiB;
constexpr size_t WS_W = 8 * MiB, W_LAYER = 161 * MiB;
constexpr size_t W_GU1 = 0, W_D1 = 44 * MiB, W_IN = 66 * MiB, W_OUT = 87 * MiB, W_GU2 = 95 * MiB, W_D2 = 139 * MiB;
constexpr size_t WS_H = 330 * MiB, WS_Y = 394 * MiB, WS_KV = 330 * MiB;
constexpr size_t WS_ACT = 458 * MiB;
constexpr size_t WS_MIX = 634 * MiB, WS_ST = 698 * MiB, WS_END = 762 * MiB;
static_assert(WS_W + 2 * W_LAYER <= WS_H && WS_ACT + (size_t)M * FF * 2 <= WS_MIX, "d_ws map");
constexpr int CW_BAR = 4096;
constexpr int RING_BYTES = 139264;
constexpr int LDSCTL_OFF = RING_BYTES, MISC_OFF = LDSCTL_OFF + 320;
constexpr int LDS_BYTES = 147456;

#define GAS __attribute__((address_space(1)))
#define LAS __attribute__((address_space(3)))
typedef unsigned short bf16;
typedef unsigned v4u __attribute__((ext_vector_type(4)));
typedef unsigned v2u __attribute__((ext_vector_type(2)));
typedef float f32x4 __attribute__((ext_vector_type(4)));
typedef float f32x2 __attribute__((ext_vector_type(2)));
typedef short bf16x8 __attribute__((ext_vector_type(8)));
typedef GAS unsigned gu32;
#define RLX_AGENT __ATOMIC_RELAXED, __HIP_MEMORY_SCOPE_AGENT
#define LDS_WAIT() asm volatile("s_waitcnt lgkmcnt(0)" ::: "memory")
#define VM_WAIT() asm volatile("s_waitcnt vmcnt(0)" ::: "memory")
__device__ __forceinline__ unsigned f2bf(float f) { unsigned u = __builtin_bit_cast(unsigned, f); return (u + 0x7fffu + ((u >> 16) & 1u)) >> 16; }
__device__ __forceinline__ unsigned pk2(float lo, float hi) { return f2bf(lo) | (f2bf(hi) << 16); }
__device__ __forceinline__ float bflo(unsigned u) { return __builtin_bit_cast(float, u << 16); }
__device__ __forceinline__ float bfhi(unsigned u) { return __builtin_bit_cast(float, u & 0xffff0000u); }
__device__ __forceinline__ float bf2f(bf16 b) { return __builtin_bit_cast(float, (unsigned)b << 16); }
__device__ __forceinline__ float wave_sum(float v) {
#pragma unroll
    for (int o = 1; o < 64; o <<= 1) v += __shfl_xor(v, o);
    return v;
}
__device__ __forceinline__ float wave_max(float v) {
#pragma unroll
    for (int o = 1; o < 64; o <<= 1) v = fmaxf(v, __shfl_xor(v, o));
    return v;
}
__device__ __forceinline__ float rdlane(float v, int l) { return __builtin_bit_cast(float, __builtin_amdgcn_readlane(__builtin_bit_cast(int, v), l)); }
__device__ __forceinline__ float silu_f(float g) { return g / (1.0f + __expf(-g)); }
__device__ __forceinline__ float lg2gamma(int hr) { return log2f(1.0f - exp2f(-5.0f - (float)hr)); }
#define XB_TMO      128
#define XB_XCNT(j)  (256  + 64 * (j))
#define XB_XSUB(j)  (1280 + 64 * (j))
#define XB_XGEN(j)  (2304 + 64 * (j))
#define XB_TOP      3328
#define XB_TOPGEN   3392
#define XCD_BAR_WORDS 3456
#define XB_SPIN_CAP (1u << 18)

__device__ __forceinline__ unsigned xb_ld(unsigned* p)              { return __hip_atomic_load(p, __ATOMIC_RELAXED, __HIP_MEMORY_SCOPE_AGENT); }
__device__ __forceinline__ unsigned xb_add(unsigned* p, unsigned v) { return __hip_atomic_fetch_add(p, v, __ATOMIC_RELAXED, __HIP_MEMORY_SCOPE_AGENT); }
__device__ __forceinline__ unsigned xb_xcc_id() { return (unsigned)__builtin_amdgcn_s_getreg((3 << 11) | 20) & 0xFu; }
#define XB_SPIN(cond, bar) do { unsigned _sp = 0; while (cond) { __builtin_amdgcn_s_sleep(1); \
    if ((++_sp & 255u) == 0u) { if (xb_ld(&(bar)[XB_TMO])) break; if (_sp > XB_SPIN_CAP) { atomicAdd(&(bar)[XB_TMO], 1u); break; } } } } while (0)

struct XcdBarrier {
    unsigned* bar; unsigned x;
    volatile LAS unsigned* st;
};

__device__ __forceinline__ XcdBarrier xcd_barrier_post(unsigned* bar, volatile LAS unsigned* st) {
    XcdBarrier b; b.bar = bar; b.x = xb_xcc_id(); b.st = st;
    if (threadIdx.x == 0) (void)xb_add(&bar[XB_XCNT(b.x)], 1u);
    return b;
}
__device__ __forceinline__ void xcd_barrier_complete(unsigned* bar, unsigned x, unsigned& nloc, unsigned& nx) {
    const unsigned G = gridDim.x * gridDim.y * gridDim.z;
    unsigned sum, cnt, mine, sp = 0u;
    for (;;) {
        sum = 0u; cnt = 0u; mine = 0u;
#pragma unroll
        for (unsigned j = 0; j < 16; ++j) { const unsigned c = xb_ld(&bar[XB_XCNT(j)]); sum += c; cnt += (c > 0u) ? 1u : 0u; mine = (j == x) ? c : mine; }
        if (sum == G) break;
        __builtin_amdgcn_s_sleep(1);
        if ((++sp & 255u) == 0u) { if (xb_ld(&bar[XB_TMO])) break; if (sp > XB_SPIN_CAP) { atomicAdd(&bar[XB_TMO], 1u); break; } }
    }
    nloc = mine > 0u ? mine : 1u; nx = cnt > 0u ? cnt : 1u;
}

__device__ __forceinline__ void xcd_barrier(const XcdBarrier& b) {
    asm volatile("s_waitcnt vmcnt(0)" ::: "memory");
    __syncthreads();
    if (threadIdx.x == 0) {
        unsigned* bar = b.bar;
        __builtin_amdgcn_s_waitcnt(0);
        unsigned nloc = b.st[0], nx = b.st[1];
        if (nloc == 0u) { xcd_barrier_complete(bar, b.x, nloc, nx); b.st[0] = nloc; b.st[1] = nx; }
        const unsigned old = xb_add(&bar[XB_XSUB(b.x)], 1u);
        const unsigned gen = old / nloc;
        if (old + 1u == (gen + 1u) * nloc) {
            __builtin_amdgcn_fence(__ATOMIC_RELEASE, "agent");
            asm volatile("s_waitcnt vmcnt(0)" ::: "memory");
            const unsigned og = xb_add(&bar[XB_TOP], 1u);
            const unsigned tg = og / nx;
            if (og + 1u == (tg + 1u) * nx) xb_add(&bar[XB_TOPGEN], 1u);
            else XB_SPIN(xb_ld(&bar[XB_TOPGEN]) == tg, bar);
            __builtin_amdgcn_fence(__ATOMIC_ACQUIRE, "agent");
            xb_add(&bar[XB_XGEN(b.x)], 1u);
            asm volatile("s_waitcnt vmcnt(0)" ::: "memory");
        } else {
            XB_SPIN(xb_ld(&bar[XB_XGEN(b.x)]) == gen, bar);
            __builtin_amdgcn_fence(__ATOMIC_ACQUIRE, "agent");
            asm volatile("s_waitcnt vmcnt(0)" ::: "memory");
        }
    }
    __syncthreads();
}
__device__ __forceinline__ void transpose_item(const float* W, int K, int N, bf16* WT, int k0, int n0, int dst_row0, LAS float* scr, int lane) {
    f32x4 v[16];
#pragma unroll
    for (int i = 0; i < 16; ++i) { const int kk = 4 * i + (lane >> 4); v[i] = *(const GAS f32x4*)(W + (size_t)(k0 + kk) * N + n0 + 4 * (lane & 15)); }
#pragma unroll
    for (int i = 0; i < 16; ++i) { const int kk = 4 * i + (lane >> 4); LAS float* d = scr + kk * 65 + 4 * (lane & 15); d[0] = v[i].x; d[1] = v[i].y; d[2] = v[i].z; d[3] = v[i].w; }
    LDS_WAIT(); asm volatile("" ::: "memory");
    const int c = lane & 7;
#pragma unroll
    for (int j = 0; j < 8; ++j) { const int n = (lane >> 3) + 8 * j; const LAS float* s = scr + (8 * c) * 65 + n;
        v4u o; o.x = pk2(s[0 * 65], s[1 * 65]); o.y = pk2(s[2 * 65], s[3 * 65]); o.z = pk2(s[4 * 65], s[5 * 65]); o.w = pk2(s[6 * 65], s[7 * 65]);
        *(GAS v4u*)(WT + (size_t)(dst_row0 + n) * K + k0 + 8 * c) = o; }
    LDS_WAIT(); asm volatile("" ::: "memory");
}
__device__ __forceinline__ void mods_partial_item(const float* cvec, const float* w_ada, float* modp, int item, int lane) {
    const int ks = item & 15, jb = (item >> 4) % 72, l = item / (16 * 72);
    const float c0 = cvec[ks * 128 + lane], c1 = cvec[ks * 128 + 64 + lane];
    const float a0 = silu_f(c0), a1 = silu_f(c1);
    const float* W = w_ada + ((size_t)l * D + ks * 128) * NADA + jb * 256 + 4 * lane;
    f32x4 acc = {0.f, 0.f, 0.f, 0.f};
#pragma unroll 16
    for (int kk = 0; kk < 64; ++kk) { const float s = rdlane(a0, kk); const f32x4 w = *(const GAS f32x4*)(W + (size_t)kk * NADA); acc += s * w; }
#pragma unroll 16
    for (int kk = 0; kk < 64; ++kk) { const float s = rdlane(a1, kk); const f32x4 w = *(const GAS f32x4*)(W + (size_t)(64 + kk) * NADA); acc += s * w; }
    *(GAS f32x4*)(modp + (size_t)ks * (2 * NADA) + l * NADA + jb * 256 + 4 * lane) = acc;
}
struct WSrc { const float *g1, *u1, *d1, *win, *wout, *g2, *u2, *d2; };
__device__ __forceinline__ void p_conv(LAS unsigned char* lds, const WSrc& S, const float* cvec, const float* w_ada, unsigned char* ws, int gw, int NGW, int wave, int lane) {
    LAS float* scr = (LAS float*)(lds + wave * 17408);
    for (int it = gw; it < 2 * 72 * 16; it += NGW) mods_partial_item(cvec, w_ada, (float*)(ws + WS_MODP), it, lane);
    constexpr int I_F = 32 * 88, I_IN = 32 * 84, I_OUT = 32 * 32, I_LAYER = 6 * I_F + I_IN + I_OUT;
    for (int it = gw; it < DEPTH * I_LAYER; it += NGW) {
        const int l = it / I_LAYER; int r = it % I_LAYER;
        unsigned char* wl = ws + WS_W + (size_t)l * W_LAYER;
        const float* W; bf16* WT; int K, N, mode = 0;
        if (r < I_F) { W = S.g1 + (size_t)l * D * FF; WT = (bf16*)(wl + W_GU1); K = D; N = FF; mode = 1; }
        else if ((r -= I_F) < I_F) { W = S.u1 + (size_t)l * D * FF; WT = (bf16*)(wl + W_GU1); K = D; N = FF; mode = 2; }
        else if ((r -= I_F) < I_F) { W = S.d1 + (size_t)l * D * FF; WT = (bf16*)(wl + W_D1); K = FF; N = D; }
        else if ((r -= I_F) < I_IN) { W = S.win + (size_t)l * D * INW; WT = (bf16*)(wl + W_IN); K = D; N = INW; }
        else if ((r -= I_IN) < I_OUT) { W = S.wout + (size_t)l * D * D; WT = (bf16*)(wl + W_OUT); K = D; N = D; }
        else if ((r -= I_OUT) < I_F) { W = S.g2 + (size_t)l * D * FF; WT = (bf16*)(wl + W_GU2); K = D; N = FF; mode = 1; }
        else if ((r -= I_F) < I_F) { W = S.u2 + (size_t)l * D * FF; WT = (bf16*)(wl + W_GU2); K = D; N = FF; mode = 2; }
        else { r -= I_F; W = S.d2 + (size_t)l * D * FF; WT = (bf16*)(wl + W_D2); K = FF; N = D; }
        const int nblk = N / 64, kb = r / nblk, nb = r % nblk, n0 = 64 * nb;
        const int drow = mode == 0 ? n0 : (256 * (n0 >> 7) + (n0 & 127) + (mode == 2 ? 128 : 0));
        transpose_item(W, K, N, WT, 64 * kb, n0, drow, scr, lane);
    }
}
__device__ __forceinline__ void p_fin(const float* modp, const float* b_ada, const float* npre, const float* npost, float* modc, int gtid, int nthr) {
    for (int i = gtid; i < DEPTH * 3 * D; i += nthr) {
        const int l = i / (3 * D), s = (i / D) % 3, c = i % D;
        float m[3];
#pragma unroll
        for (int t = 0; t < 3; ++t) { const int j = l * NADA + s * (3 * D) + t * D + c; float sum = b_ada[j];
#pragma unroll
            for (int ks = 0; ks < 16; ++ks) sum += modp[(size_t)ks * (2 * NADA) + j];
            m[t] = sum; }
        const float w = (s == 1) ? 1.0f : 0.5f;
        float* o = modc + (size_t)((l * 3 + s) * 3) * D + c;
        o[0] = npre[(l * 3 + s) * D + c] * (1.0f + m[1]); o[D] = m[0]; o[2 * D] = w * m[2] * npost[(l * 3 + s) * D + c];
    }
}
template <bool POST, bool PRE>
__device__ __forceinline__ void thin_phase(LAS unsigned char* lds, const float* xsrc, const bf16* y, float* xdst, bf16* h, const float* cA, const float* cB, const float* cP,
                                           int gw, int NGW, int tid, int lane) {
    LAS float* LA = (LAS float*)lds; LAS float* LB = LA + D; LAS float* LP = LB + D;
    for (int i = tid; i < D; i += NWAVES * 64) { if (PRE) { LA[i] = cA[i]; LB[i] = cB[i]; } if (POST) LP[i] = cP[i]; }
    __syncthreads();
    for (int r = gw; r < M; r += NGW) {
        f32x4 xv[4][2]; v4u yr[4];
        const float* xr = xsrc + (size_t)r * D + 8 * lane;
#pragma unroll
        for (int j = 0; j < 4; ++j) { xv[j][0] = *(const GAS f32x4*)(xr + 512 * j); xv[j][1] = *(const GAS f32x4*)(xr + 512 * j + 4); }
        if (POST) {
#pragma unroll
            for (int j = 0; j < 4; ++j) yr[j] = *(const GAS v4u*)(y + (size_t)r * D + 512 * j + 8 * lane);
            float ssq = 0.f; f32x4 yv[4][2];
#pragma unroll
            for (int j = 0; j < 4; ++j) { yv[j][0] = (f32x4){bflo(yr[j].x), bfhi(yr[j].x), bflo(yr[j].y), bfhi(yr[j].y)}; yv[j][1] = (f32x4){bflo(yr[j].z), bfhi(yr[j].z), bflo(yr[j].w), bfhi(yr[j].w)};
#pragma unroll
                for (int q = 0; q < 2; ++q) ssq += (yv[j][q].x * yv[j][q].x + yv[j][q].y * yv[j][q].y) + (yv[j][q].z * yv[j][q].z + yv[j][q].w * yv[j][q].w); }
            const float rstd = 1.0f / sqrtf(wave_sum(ssq) * (1.0f / D) + NORM_EPS);
            float* xo = xdst + (size_t)r * D + 8 * lane;
#pragma unroll
            for (int j = 0; j < 4; ++j)
#pragma unroll
                for (int q = 0; q < 2; ++q) { const f32x4 p = *(const LAS f32x4*)(LP + 512 * j + 8 * lane + 4 * q); xv[j][q] = xv[j][q] + p * yv[j][q] * rstd; *(GAS f32x4*)(xo + 512 * j + 4 * q) = xv[j][q]; }
        }
        if (PRE) {
            float ssq = 0.f;
#pragma unroll
            for (int j = 0; j < 4; ++j)
#pragma unroll
                for (int q = 0; q < 2; ++q) ssq += (xv[j][q].x * xv[j][q].x + xv[j][q].y * xv[j][q].y) + (xv[j][q].z * xv[j][q].z + xv[j][q].w * xv[j][q].w);
            const float rstd = 1.0f / sqrtf(wave_sum(ssq) * (1.0f / D) + NORM_EPS);
#pragma unroll
            for (int j = 0; j < 4; ++j) { f32x4 o[2];
#pragma unroll
                for (int q = 0; q < 2; ++q) { const f32x4 a = *(const LAS f32x4*)(LA + 512 * j + 8 * lane + 4 * q), b = *(const LAS f32x4*)(LB + 512 * j + 8 * lane + 4 * q); o[q] = xv[j][q] * rstd * a + b; }
                v4u w; w.x = pk2(o[0].x, o[0].y); w.y = pk2(o[0].z, o[0].w); w.z = pk2(o[1].x, o[1].y); w.w = pk2(o[1].z, o[1].w);
                *(GAS v4u*)(h + (size_t)r * D + 512 * j + 8 * lane) = w; }
        }
    }
    __syncthreads();
}
__device__ __forceinline__ void ret_scan(const float* kv, bf16* st, int gtid, int nthr) {
    for (int p = gtid; p < 4 * 32768; p += nthr) {
        const int hr = p >> 15, pp = p & 32767;
        const float decay = exp2f(128.0f * lg2gamma(hr));
        const float* kp = kv + (size_t)hr * 65536 + 2 * pp; bf16* sp = st + (size_t)hr * 65536 + 2 * pp;
        f32x2 s = {0.f, 0.f};
#pragma unroll 8
        for (int n = 0; n < 128; ++n) {
            *(GAS unsigned*)(sp + (size_t)n * 262144) = pk2(s.x, s.y);
            const f32x2 k = *(const GAS f32x2*)(kp + (size_t)n * 262144);
            s = s * decay + k;
        }
    }
}
#if SIMPLE_MIX
__device__ __forceinline__ void attn_simple(const bf16* proj, bf16* mix, const float* sinks, int gw, int NGW, int lane) {
    for (int it = gw; it < M * 16; it += NGW) {
        const int t = it >> 4, hq = it & 15, kh = hq >> 3;
        const float slope = exp2f(-0.5f * (float)(hq + 1)), sink = sinks[hq];
        const bf16* qp = proj + (size_t)t * INW + OFF_QA + hq * 64;
        float q[64];
#pragma unroll
        for (int c = 0; c < 8; ++c) { const v4u r = *(const GAS v4u*)(qp + 8 * c); q[8 * c + 0] = bflo(r.x); q[8 * c + 1] = bfhi(r.x); q[8 * c + 2] = bflo(r.y); q[8 * c + 3] = bfhi(r.y);
            q[8 * c + 4] = bflo(r.z); q[8 * c + 5] = bfhi(r.z); q[8 * c + 6] = bflo(r.w); q[8 * c + 7] = bfhi(r.w); }
        float sc[2];
#pragma unroll
        for (int kk = 0; kk < 2; ++kk) { const int s = t - 127 + lane + 64 * kk; float dot = 0.f;
            if (s >= 0) { const bf16* kp = proj + (size_t)s * INW + OFF_KA + kh * 64;
#pragma unroll
                for (int c = 0; c < 8; ++c) { const v4u r = *(const GAS v4u*)(kp + 8 * c);
                    dot += q[8 * c + 0] * bflo(r.x) + q[8 * c + 1] * bfhi(r.x) + q[8 * c + 2] * bflo(r.y) + q[8 * c + 3] * bfhi(r.y) + q[8 * c + 4] * bflo(r.z) + q[8 * c + 5] * bfhi(r.z) + q[8 * c + 6] * bflo(r.w) + q[8 * c + 7] * bfhi(r.w); } }
            const float dist = (float)(127 - lane - 64 * kk); sc[kk] = (s >= 0) ? dot * 0.125f - slope * dist : -INFINITY; }
        float m = wave_max(fmaxf(sc[0], sc[1])); m = fmaxf(m, sink);
        const float p0 = __expf(sc[0] - m), p1 = __expf(sc[1] - m);
        const float denom = wave_sum(p0 + p1) + __expf(sink - m);
        float o = 0.f;
        const bf16* vp = proj + OFF_VA + kh * 64 + lane;
        for (int j = 0; j < 64; ++j) { const int s = t - 127 + j; const float pj = rdlane(p0, j); if (s >= 0) o += pj * bf2f(vp[(size_t)s * INW]); }
        for (int j = 0; j < 64; ++j) { const int s = t - 63 + j; const float pj = rdlane(p1, j); if (s >= 0) o += pj * bf2f(vp[(size_t)s * INW]); }
        mix[(size_t)t * D + hq * 64 + lane] = (bf16)f2bf(o / denom);
    }
}
__device__ __forceinline__ void ret_kv_simple(const bf16* proj, float* kv, int n, int hr, int tid) {
    const int e4 = tid & 63, w = tid >> 6; const float lg = lg2gamma(hr);
    const bf16* Kb = proj + (size_t)(n * 128) * INW + OFF_KR + hr * 256; const bf16* Vb = proj + (size_t)(n * 128) * INW + OFF_VR + hr * 256 + 4 * e4;
    for (int dc = 0; dc < 4; ++dc) { const int d0 = 32 * w + 8 * dc; f32x4 acc[8];
#pragma unroll
        for (int dd = 0; dd < 8; ++dd) acc[dd] = (f32x4){0.f, 0.f, 0.f, 0.f};
        for (int j = 0; j < 128; ++j) { const float z = exp2f(lg * (float)(127 - j)) * 0.0625f;
            const v2u vr = *(const GAS v2u*)(Vb + (size_t)j * INW); const f32x4 v = {bflo(vr.x), bfhi(vr.x), bflo(vr.y), bfhi(vr.y)};
            const v4u kr = *(const GAS v4u*)(Kb + (size_t)j * INW + d0);
            const float k[8] = {bflo(kr.x) * z, bfhi(kr.x) * z, bflo(kr.y) * z, bfhi(kr.y) * z, bflo(kr.z) * z, bfhi(kr.z) * z, bflo(kr.w) * z, bfhi(kr.w) * z};
#pragma unroll
            for (int dd = 0; dd < 8; ++dd) acc[dd] += k[dd] * v; }
#pragma unroll
        for (int dd = 0; dd < 8; ++dd) *(GAS f32x4*)(kv + ((size_t)(n * 4 + hr) * 256 + d0 + dd) * 256 + 4 * e4) = acc[dd]; }
}
__device__ __forceinline__ void ret_out_simple(LAS unsigned char* lds, const bf16* proj, const bf16* state, bf16* mix, int n, int hr, int tid) {
    LAS float* S = (LAS float*)lds;
    const float lg = lg2gamma(hr);
    const bf16* Qb = proj + (size_t)(n * 128) * INW + OFF_QR + hr * 256; const bf16* Kb = proj + (size_t)(n * 128) * INW + OFF_KR + hr * 256;
    const bf16* Vb = proj + (size_t)(n * 128) * INW + OFF_VR + hr * 256; const bf16* Gb = proj + (size_t)(n * 128) * INW + OFF_GR + hr * 256;
    {
        const int i = tid >> 2, jq = tid & 3; float acc[32];
#pragma unroll
        for (int jj = 0; jj < 32; ++jj) acc[jj] = 0.f;
        for (int dc = 0; dc < 32; ++dc) { const v4u qr = *(const GAS v4u*)(Qb + (size_t)i * INW + 8 * dc);
            const float q0 = bflo(qr.x), q1 = bfhi(qr.x), q2 = bflo(qr.y), q3 = bfhi(qr.y), q4 = bflo(qr.z), q5 = bfhi(qr.z), q6 = bflo(qr.w), q7 = bfhi(qr.w);
#pragma unroll
            for (int jj = 0; jj < 32; ++jj) { const v4u kr = *(const GAS v4u*)(Kb + (size_t)(jq + 4 * jj) * INW + 8 * dc);
                acc[jj] += q0 * bflo(kr.x) + q1 * bfhi(kr.x) + q2 * bflo(kr.y) + q3 * bfhi(kr.y) + q4 * bflo(kr.z) + q5 * bfhi(kr.z) + q6 * bflo(kr.w) + q7 * bfhi(kr.w); } }
#pragma unroll
        for (int jj = 0; jj < 32; ++jj) { const int j = jq + 4 * jj; S[i * 129 + j] = (j <= i) ? acc[jj] * exp2f(lg * (float)(i - j)) * 0.0625f : 0.f; }
    }
    __syncthreads();
    {
        const int e4 = tid & 63, w = tid >> 6;
#pragma nounroll
        for (int hh = 0; hh < 2; ++hh) {
        int r0 = 16 * w + 8 * hh; asm volatile("" : "+v"(r0));
        f32x4 o[8];
#pragma unroll
        for (int ii = 0; ii < 8; ++ii) o[ii] = (f32x4){0.f, 0.f, 0.f, 0.f};
        if (n > 0) {
            const bf16* St = state + (size_t)(n * 4 + hr) * 65536 + 4 * e4;
            const bf16* Qr = Qb + (size_t)r0 * INW;
            for (int dc = 0; dc < 32; ++dc) { f32x4 sv[8];
#pragma unroll
                for (int dd = 0; dd < 8; ++dd) { const v2u r = *(const GAS v2u*)(St + (size_t)(8 * dc + dd) * 256); sv[dd] = (f32x4){bflo(r.x), bfhi(r.x), bflo(r.y), bfhi(r.y)}; }
#pragma unroll
                for (int ii = 0; ii < 8; ++ii) { const v4u qr = *(const GAS v4u*)(Qr + (size_t)ii * INW + 8 * dc);
                    o[ii] += bflo(qr.x) * sv[0] + bfhi(qr.x) * sv[1] + bflo(qr.y) * sv[2] + bfhi(qr.y) * sv[3] + bflo(qr.z) * sv[4] + bfhi(qr.z) * sv[5] + bflo(qr.w) * sv[6] + bfhi(qr.w) * sv[7]; } }
#pragma unroll
            for (int ii = 0; ii < 8; ++ii) o[ii] = o[ii] * exp2f(lg * (float)(r0 + ii + 1));
        }
        for (int j = 0; j < r0 + 8; ++j) { const v2u r = *(const GAS v2u*)(Vb + (size_t)j * INW + 4 * e4); const f32x4 v = {bflo(r.x), bfhi(r.x), bflo(r.y), bfhi(r.y)};
#pragma unroll
            for (int ii = 0; ii < 8; ++ii) o[ii] += S[(r0 + ii) * 129 + j] * v; }
#pragma unroll
        for (int ii = 0; ii < 8; ++ii) { const int i = r0 + ii;
            const float mu = wave_sum((o[ii].x + o[ii].y) + (o[ii].z + o[ii].w)) * (1.0f / 256.0f);
            const f32x4 dv = o[ii] - mu;
            const float var = wave_sum((dv.x * dv.x + dv.y * dv.y) + (dv.z * dv.z + dv.w * dv.w)) * (1.0f / 256.0f);
            const float rstd = 1.0f / sqrtf(var + GN_EPS);
            const v2u gr = *(const GAS v2u*)(Gb + (size_t)i * INW + 4 * e4);
            const f32x4 y = {silu_f(bflo(gr.x)) * dv.x * rstd, silu_f(bfhi(gr.x)) * dv.y * rstd, silu_f(bflo(gr.y)) * dv.z * rstd, silu_f(bfhi(gr.y)) * dv.w * rstd};
            v2u wv; wv.x = pk2(y.x, y.y); wv.y = pk2(y.z, y.w);
            *(GAS v2u*)(mix + (size_t)(n * 128 + i) * D + 1024 + hr * 256 + 4 * e4) = wv; }
        }
    }
    __syncthreads();
}
#endif
struct Args { const float* in[15]; float* out; unsigned char* ws; int ph_lo, ph_hi, li, pad; };
__global__ void __launch_bounds__(NWAVES * 64, 2) mega_fwd(Args args) {
    extern __shared__ __attribute__((aligned(16))) unsigned char lds_raw[];
    LAS unsigned char* lds = (LAS unsigned char*)lds_raw;
    volatile LAS unsigned* MISC = (volatile LAS unsigned*)(lds + MISC_OFF);
    const int tid = threadIdx.x, lane = tid & 63, wave = __builtin_amdgcn_readfirstlane(tid >> 6);
    const int G = gridDim.x, bx = blockIdx.x, vcu = (G % 8 == 0) ? (bx % 8) * (G / 8) + bx / 8 : bx;
    const int gw = vcu * NWAVES + wave, NGW = G * NWAVES, gtid = vcu * (NWAVES * 64) + tid, nthr = G * NWAVES * 64;
    unsigned char* ws = args.ws;
    gu32* ctl = (gu32*)(ws + WS_CTL);
    for (int u = tid; u < (LDS_BYTES - LDSCTL_OFF) / 4; u += NWAVES * 64) ((LAS unsigned*)(lds + LDSCTL_OFF))[u] = 0u;
    __syncthreads();
    XcdBarrier bar; bar.bar = (unsigned*)(ctl + CW_BAR) + args.li * XCD_BAR_WORDS; bar.x = 0; bar.st = nullptr;
    const int lo = args.ph_lo, hi = args.ph_hi;
    if (hi - lo > 1) bar = xcd_barrier_post((unsigned*)(ctl + CW_BAR) + args.li * XCD_BAR_WORDS, MISC + 8);
#define IN(k) (lo <= (k) && (k) < hi)
#define SEAM(k) do { if (IN((k) + 1)) xcd_barrier(bar); } while (0)
#define OPQ(p) asm volatile("" : "+s"(p))
#define PHASE_PTRS unsigned char* w = ws; OPQ(w); float* out = args.out; OPQ(out); int tid_ = threadIdx.x; asm volatile("" : "+v"(tid_)); const int lane_ = tid_ & 63; int gw_ = gw; OPQ(gw_); const int gtid_ = vcu * (NWAVES * 64) + tid_; (void)lane_; (void)gw_; (void)gtid_; \
    bf16* Hb = (bf16*)(w + WS_H); bf16* Yb = (bf16*)(w + WS_Y); bf16* ACT = (bf16*)(w + WS_ACT); bf16* PROJ = (bf16*)(w + WS_ACT); bf16* MIX = (bf16*)(w + WS_MIX); \
    float* KV = (float*)(w + WS_KV); bf16* ST = (bf16*)(w + WS_ST); float* modp = (float*)(w + WS_MODP); float* modc = (float*)(w + WS_MODC); \
    (void)out; (void)Hb; (void)Yb; (void)ACT; (void)PROJ; (void)MIX; (void)KV; (void)ST; (void)modp; (void)modc;

    if (IN(0)) { PHASE_PTRS WSrc S{args.in[6], args.in[7], args.in[8], args.in[9], args.in[10], args.in[12], args.in[13], args.in[14]};
        p_conv(lds, S, args.in[1], args.in[2], w, gw_, NGW, wave, lane_); SEAM(0); }
    if (IN(1)) { PHASE_PTRS p_fin(modp, args.in[3], args.in[4], args.in[5], modc, gtid_, nthr); SEAM(1); }
    if (IN(2)) { PHASE_PTRS thin_phase<false, true>(lds, args.in[0], nullptr, nullptr, Hb, modc, modc + D, nullptr, gw_, NGW, tid_, lane_); SEAM(2); }
#pragma nounroll
    for (int l = 0; l < DEPTH; ++l) {
        const int pb = 3 + 12 * l;
#define LAYER_PTRS PHASE_PTRS unsigned char* wl = w + WS_W + (size_t)l * W_LAYER; const float* mc = modc + (size_t)l * 9 * D; (void)wl; (void)mc;
        if (IN(pb + 0)) { LAYER_PTRS pg8::Gemm g{Hb, (const bf16*)(wl + W_GU1), M, 2 * FF, D}; pg8::StaticOrder S; S.init(M, 2 * FF, G, bx);
            pg8::EpiSwiGLU E{ACT, FF}; pg8::gemm_phase<pg8::EpiSwiGLU, pg8::StaticOrder, PG8_ALIGN, PG8_SP2>(lds, g, S, E, tid_); SEAM(pb + 0); }
        if (IN(pb + 1)) { LAYER_PTRS pg8::Gemm g{ACT, (const bf16*)(wl + W_D1), M, D, FF}; pg8::StaticOrder S; S.init(M, D, G, bx);
            pg8::EpiBf16 E{Yb, D}; pg8::gemm_phase<pg8::EpiBf16, pg8::StaticOrder, PG8_ALIGN, PG8_SP2>(lds, g, S, E, tid_); SEAM(pb + 1); }
        if (IN(pb + 2)) { LAYER_PTRS const float* xs = l == 0 ? args.in[0] : out; thin_phase<true, true>(lds, xs, Yb, out, Hb, mc + 3 * D, mc + 4 * D, mc + 2 * D, gw_, NGW, tid_, lane_); SEAM(pb + 2); }
        if (IN(pb + 3)) { LAYER_PTRS pg8::Gemm g{Hb, (const bf16*)(wl + W_IN), M, INW, D}; pg8::StaticOrder S; S.init(M, INW, G, bx);
            pg8::EpiBf16 E{PROJ, INW}; pg8::gemm_phase<pg8::EpiBf16, pg8::StaticOrder, PG8_ALIGN, PG8_SP2>(lds, g, S, E, tid_); SEAM(pb + 3); }
        if (IN(pb + 4)) { LAYER_PTRS
#if SIMPLE_MIX
            attn_simple(PROJ, MIX, args.in[11] + l * 16, gw_, NGW, lane_);
            for (int u = vcu; u < 512; u += G) ret_kv_simple(PROJ, KV, u >> 2, u & 3, tid_);
#endif
            SEAM(pb + 4); }
        if (IN(pb + 5)) { LAYER_PTRS ret_scan(KV, ST, gtid_, nthr); SEAM(pb + 5); }
        if (IN(pb + 6)) { LAYER_PTRS
#if SIMPLE_MIX
            for (int u = vcu; u < 512; u += G) ret_out_simple(lds, PROJ, ST, MIX, u >> 2, u & 3, tid_);
#endif
            SEAM(pb + 6); }
        if (IN(pb + 7)) { LAYER_PTRS pg8::Gemm g{MIX, (const bf16*)(wl + W_OUT), M, D, D}; pg8::StaticOrder S; S.init(M, D, G, bx);
            pg8::EpiBf16 E{Yb, D}; pg8::gemm_phase<pg8::EpiBf16, pg8::StaticOrder, PG8_ALIGN, PG8_SP2>(lds, g, S, E, tid_); SEAM(pb + 7); }
        if (IN(pb + 8)) { LAYER_PTRS thin_phase<true, true>(lds, out, Yb, out, Hb, mc + 6 * D, mc + 7 * D, mc + 5 * D, gw_, NGW, tid_, lane_); SEAM(pb + 8); }
        if (IN(pb + 9)) { LAYER_PTRS pg8::Gemm g{Hb, (const bf16*)(wl + W_GU2), M, 2 * FF, D}; pg8::StaticOrder S; S.init(M, 2 * FF, G, bx);
            pg8::EpiSwiGLU E{ACT, FF}; pg8::gemm_phase<pg8::EpiSwiGLU, pg8::StaticOrder, PG8_ALIGN, PG8_SP2>(lds, g, S, E, tid_); SEAM(pb + 9); }
        if (IN(pb + 10)) { LAYER_PTRS pg8::Gemm g{ACT, (const bf16*)(wl + W_D2), M, D, FF}; pg8::StaticOrder S; S.init(M, D, G, bx);
            pg8::EpiBf16 E{Yb, D}; pg8::gemm_phase<pg8::EpiBf16, pg8::StaticOrder, PG8_ALIGN, PG8_SP2>(lds, g, S, E, tid_); SEAM(pb + 10); }
        if (IN(pb + 11)) { LAYER_PTRS
            if (l + 1 < DEPTH) thin_phase<true, true>(lds, out, Yb, out, Hb, mc + 9 * D, mc + 10 * D, mc + 8 * D, gw_, NGW, tid_, lane_);
            else thin_phase<true, false>(lds, out, Yb, out, nullptr, nullptr, nullptr, mc + 8 * D, gw_, NGW, tid_, lane_);
            SEAM(pb + 11); }
    }
#undef IN
#undef SEAM
}

extern "C" void kernel_launch(void* const* d_in, const int* in_sizes, int n_in, void* d_out, int out_size, void* d_ws, size_t ws_size, hipStream_t stream) {
    static int grid = 0;
    if (grid == 0) {
        if (n_in != 15 || in_sizes[0] != M * D || out_size != M * D || ws_size < WS_END) { fprintf(stderr, "kernel_launch: shape/workspace mismatch (n_in %d, in0 %d, out %d, ws %zu)\n", n_in, n_in > 0 ? in_sizes[0] : -1, out_size, ws_size); grid = -1; return; }
        int dev = 0, cus = 0, per_cu = 0;
        if (hipGetDevice(&dev) != hipSuccess || hipDeviceGetAttribute(&cus, hipDeviceAttributeMultiprocessorCount, dev) != hipSuccess) { grid = -1; return; }
        if (hipFuncSetAttribute((const void*)mega_fwd, hipFuncAttributeMaxDynamicSharedMemorySize, LDS_BYTES) != hipSuccess) { fprintf(stderr, "kernel_launch: hipFuncSetAttribute failed\n"); grid = -1; return; }
        if (hipOccupancyMaxActiveBlocksPerMultiprocessor(&per_cu, (const void*)mega_fwd, NWAVES * 64, LDS_BYTES) != hipSuccess || per_cu < 1) fprintf(stderr, "kernel_launch: occupancy query says %d\n", per_cu);
        (void)hipGetLastError();
        grid = cus;
    }
    if (grid < 0) return;
    if (hipMemsetAsync((char*)d_ws + WS_CTL, 0, CTL_ZERO_BYTES, stream) != hipSuccess) return;
    Args a{};
    for (int i = 0; i < 15; ++i) a.in[i] = (const float*)d_in[i];
    a.out = (float*)d_out; a.ws = (unsigned char*)d_ws;
#if MK_PER_PHASE
    for (int p = 0; p < N_PHASES; ++p) { a.ph_lo = p; a.ph_hi = p + 1; a.li = 0; hipLaunchKernelGGL(mega_fwd, dim3(grid), dim3(NWAVES * 64), LDS_BYTES, stream, a); }
#else
    a.ph_lo = 0; a.ph_hi = N_PHASES; a.li = 0;
    hipLaunchKernelGGL(mega_fwd, dim3(grid), dim3(NWAVES * 64), LDS_BYTES, stream, a);
#endif
    const hipError_t le = hipPeekAtLastError();
    if (le != hipSuccess) fprintf(stderr, "kernel_launch: launch failed: %s\n", hipGetErrorName(le));
}
```

```cpp
#include <hip/hip_runtime.h>
#include <cstdio>
#include <cstdint>
namespace pg8 {
#define PG8_LAS __attribute__((address_space(3)))
typedef unsigned short bf16_t;
typedef short bf16x8 __attribute__((ext_vector_type(8)));
typedef float f32x4 __attribute__((ext_vector_type(4)));
typedef unsigned u32x4 __attribute__((ext_vector_type(4)));
constexpr int BM = 256, BK = 64, HALF = 128, HTB = HALF * BK * 2  , STAGE_BYTES = 8 * HTB, NXCD = 8, WGM = 8;

__host__ __device__ __forceinline__ int lds_byte(int r, int c) { const int st = (r >> 4) * 2 + (c >> 5), rr = r & 15, cc = c & 31, ob = rr * 64 + cc * 2; return st * 1024 + (ob ^ (((ob >> 9) & 1) << 5)); }
__host__ __device__ __forceinline__ void stage_rc(int b, int& R, int& C) { const int st = b / 1024, sb = b % 1024, swz = sb ^ (((sb >> 9) & 1) << 5); R = (st >> 1) * 16 + swz / 64; C = (st & 1) * 32 + (swz % 64) / 2; }
__host__ __device__ __forceinline__ int perm32(int rho) { const int n = rho >> 4, i = rho & 15; return 8 * (i >> 2) + 4 * n + (i & 3); }

struct Unit { int pm, pn; };
struct Gemm { const bf16_t* A; const bf16_t* Bt; int M, N, K; };

struct StaticOrder {
    int nM, nN, nwg, G, c;
    __host__ __device__ void init(int M, int N, int G_, int c_) { nM = M / BM; nN = N / BM; nwg = nM * nN; G = G_; c = c_; }
    __host__ __device__ bool next(int i, Unit& u) const {
        const long L = (long)i * G + c; if (L >= nwg) return false;
        int wgid = (int)L; { const int q = nwg / NXCD, r = nwg % NXCD, xcd = wgid % NXCD, off = wgid / NXCD; wgid = (xcd < r ? xcd * (q + 1) : r * (q + 1) + (xcd - r) * q) + off; }
        const int nig = WGM * nN, gid = wgid / nig, fm = gid * WGM, gsz = (nM - fm) < WGM ? (nM - fm) : WGM;
        u.pm = fm + ((wgid % nig) % gsz); u.pn = (wgid % nig) / gsz; return true;
    }
    __device__ __forceinline__ void a_ready(const Unit&) const {}
    __device__ __forceinline__ void done(const Unit&) const {}
};

__device__ __forceinline__ unsigned cvt_pk_bf16(float lo, float hi) { unsigned r; asm volatile("v_cvt_pk_bf16_f32 %0, %1, %2" : "=v"(r) : "v"(lo), "v"(hi)); return r; }
struct EpiBf16 {
    static constexpr bool PERM = true, AFTER_DRAIN = false;
    bf16_t* O; int ldc;
    __device__ __forceinline__ void operator()(const f32x4 (&acc)[2][2][4][2], const Unit& u, int wr, int wc, int fr, int fq) const {
        const int row0 = u.pm * BM + wr * 64 + fr; const int col0 = u.pn * BM + wc * 32 + 8 * fq;
#pragma unroll
        for (int ai = 0; ai < 2; ++ai)
#pragma unroll
            for (int m = 0; m < 4; ++m) { bf16_t* rowp = O + (size_t)(row0 + ai * HALF + m * 16) * ldc + col0;
#pragma unroll
                for (int bj = 0; bj < 2; ++bj) { const f32x4 v0 = acc[ai][bj][m][0], v1 = acc[ai][bj][m][1];
                    u32x4 w; w.x = cvt_pk_bf16(v0[0], v0[1]); w.y = cvt_pk_bf16(v0[2], v0[3]); w.z = cvt_pk_bf16(v1[0], v1[1]); w.w = cvt_pk_bf16(v1[2], v1[3]);
                    *(u32x4*)(rowp + bj * HALF) = w; } }
    }
};
__device__ __forceinline__ float silu_mul(float g, float u) { return g * u * __builtin_amdgcn_rcpf(1.0f + __builtin_amdgcn_exp2f(-1.4426950408889634f * g)); }
struct EpiSwiGLU {
    static constexpr bool PERM = true, AFTER_DRAIN = false;
    bf16_t* O; int ldc;
    __device__ __forceinline__ void operator()(const f32x4 (&acc)[2][2][4][2], const Unit& u, int wr, int wc, int fr, int fq) const {
        const int row0 = u.pm * BM + wr * 64 + fr; const int col0 = u.pn * HALF + wc * 32 + 8 * fq;
#pragma unroll
        for (int ai = 0; ai < 2; ++ai)
#pragma unroll
            for (int m = 0; m < 4; ++m) { bf16_t* rowp = O + (size_t)(row0 + ai * HALF + m * 16) * ldc + col0;
                const f32x4 g0 = acc[ai][0][m][0], g1 = acc[ai][0][m][1], u0 = acc[ai][1][m][0], u1 = acc[ai][1][m][1];
                u32x4 w; w.x = cvt_pk_bf16(silu_mul(g0[0], u0[0]), silu_mul(g0[1], u0[1])); w.y = cvt_pk_bf16(silu_mul(g0[2], u0[2]), silu_mul(g0[3], u0[3]));
                w.z = cvt_pk_bf16(silu_mul(g1[0], u1[0]), silu_mul(g1[1], u1[1])); w.w = cvt_pk_bf16(silu_mul(g1[2], u1[2]), silu_mul(g1[3], u1[3]));
                *(u32x4*)rowp = w; }
    }
};

template <class Epi, class Sched, bool ALIGN_EPI = false, bool SP2 = false>
__device__ __forceinline__ void gemm_phase(PG8_LAS unsigned char* lds, const Gemm g, const Sched& S, const Epi& E, const int tid) {
    const int wid = __builtin_amdgcn_readfirstlane(tid >> 6), lane = tid & 63, wr = wid >> 2, wc = wid & 3, fr = lane & 15, fq = lane >> 4;
    const int K = g.K, nt = K / BK;
    unsigned voffA[2], voffB[2];
#pragma unroll
    for (int i = 0; i < 2; ++i) { int R, C; stage_rc(tid * 16 + i * 8192, R, C); const int Rb = Epi::PERM ? ((R & ~31) + perm32(R & 31)) : R;
        voffA[i] = (unsigned)(R * K + C) * 2u; voffB[i] = (unsigned)(Rb * K + C) * 2u; }
    const size_t kstep = (size_t)(BK * 2);
    const size_t hstep = (size_t)HALF * K * 2;
    const size_t tstep = 2 * hstep;
    const unsigned ldsw = (unsigned)wid * 1024u;
    const int aoff = lds_byte(wr * 64 + fr, fq * 8), boff = lds_byte(wc * 32 + fr, fq * 8);
#define PG8_SA(b, h) (((b) * 2 + (h)) * HTB)
#define PG8_SB(b, h) ((4 + (b) * 2 + (h)) * HTB)
#define PG8_STAGE(bufoff, gbase, voff) do { _Pragma("unroll") for (int _i = 0; _i < 2; ++_i) \
        __builtin_amdgcn_global_load_lds((const unsigned*)((const char*)(gbase) + (voff)[_i]), (PG8_LAS unsigned*)(lds + (bufoff) + ldsw + _i * 8192), 16, 0, 0); } while (0)
#define PG8_LDA(dst, b, h) do { _Pragma("unroll") for (int m = 0; m < 4; ++m) _Pragma("unroll") for (int k = 0; k < 2; ++k) dst[m][k] = *(const PG8_LAS bf16x8*)(lds + PG8_SA(b, h) + aoff + m * 2048 + k * 1024); } while (0)
#define PG8_LDB(dst, b, h) do { _Pragma("unroll") for (int n = 0; n < 2; ++n) _Pragma("unroll") for (int k = 0; k < 2; ++k) dst[n][k] = *(const PG8_LAS bf16x8*)(lds + PG8_SB(b, h) + boff + n * 2048 + k * 1024); } while (0)
#define PG8_MMA(ai, bj, At, Bt) do { __builtin_amdgcn_s_setprio(1); _Pragma("unroll") for (int m = 0; m < 4; ++m) _Pragma("unroll") for (int n = 0; n < 2; ++n) _Pragma("unroll") for (int k = 0; k < 2; ++k) \
        acc[ai][bj][m][n] = __builtin_amdgcn_mfma_f32_16x16x32_bf16(Bt[n][k], At[m][k], acc[ai][bj][m][n], 0, 0, 0); __builtin_amdgcn_s_setprio(0); } while (0)
#define PG8_WAIT_V(n) asm volatile("s_waitcnt vmcnt(" #n ")" ::: "memory")
#define PG8_WAIT_L(n) asm volatile("s_waitcnt lgkmcnt(" #n ")" ::: "memory")
#define PG8_BAR __builtin_amdgcn_s_barrier()
#define PG8_SCHED __builtin_amdgcn_sched_barrier(0)
    Unit cur, nxt; int ui = 0;
    if (!S.next(0, cur)) return;
    f32x4 acc[2][2][4][2];
#pragma unroll
    for (int a = 0; a < 2; ++a)
#pragma unroll
        for (int b = 0; b < 2; ++b)
#pragma unroll
            for (int m = 0; m < 4; ++m)
#pragma unroll
                for (int n = 0; n < 2; ++n) acc[a][b][m][n] = (f32x4){0.f, 0.f, 0.f, 0.f};
    bf16x8 At[4][2], B0[2][2], B1[2][2];
    const char* cA = (const char*)g.A + (size_t)cur.pm * tstep; const char* cB = (const char*)g.Bt + (size_t)cur.pn * tstep;
    S.a_ready(cur);
    if constexpr (SP2) {
        PG8_STAGE(PG8_SB(0, 0), cB, voffB); PG8_STAGE(PG8_SB(0, 1), cB + hstep, voffB); PG8_STAGE(PG8_SA(0, 0), cA, voffA); PG8_STAGE(PG8_SA(0, 1), cA + hstep, voffA);
        if (wr == 1) PG8_BAR;
        PG8_WAIT_V(2); PG8_BAR;
        PG8_STAGE(PG8_SB(1, 0), cB + kstep, voffB); PG8_STAGE(PG8_SA(1, 0), cA + kstep, voffA); PG8_STAGE(PG8_SB(1, 1), cB + hstep + kstep, voffB);
        PG8_WAIT_V(6); PG8_BAR;
    } else {
        PG8_STAGE(PG8_SB(0, 0), cB, voffB); PG8_STAGE(PG8_SA(0, 0), cA, voffA); PG8_STAGE(PG8_SB(0, 1), cB + hstep, voffB); PG8_STAGE(PG8_SA(0, 1), cA + hstep, voffA);
        if (wr == 1) PG8_BAR;
        PG8_WAIT_V(4); PG8_BAR;
        PG8_STAGE(PG8_SB(1, 0), cB + kstep, voffB); PG8_STAGE(PG8_SA(1, 0), cA + kstep, voffA); PG8_STAGE(PG8_SB(1, 1), cB + hstep + kstep, voffB);
        PG8_WAIT_V(6); PG8_BAR;
    }
    for (;;) {
        const bool has_next = S.next(ui + 1, nxt);
        const char* nA = has_next ? (const char*)g.A + (size_t)nxt.pm * tstep : cA; const char* nB = has_next ? (const char*)g.Bt + (size_t)nxt.pn * tstep : cB;
        for (int t = 0; t < nt; t += 2) {
            const bool last = (t == nt - 2);
            const char* a1 = cA + (size_t)(t + 1) * kstep;
            const char* a2 = last ? nA : cA + (size_t)(t + 2) * kstep; const char* b2 = last ? nB : cB + (size_t)(t + 2) * kstep;
            const char* a3 = a2 + kstep; const char* b3 = b2 + kstep;
            if (last && has_next) S.a_ready(nxt);
            if constexpr (SP2) {
            PG8_LDB(B0, 0, 0); PG8_LDB(B1, 0, 1); PG8_SCHED; PG8_LDA(At, 0, 0); PG8_STAGE(PG8_SA(1, 1), a1 + hstep, voffA);
            PG8_WAIT_V(8); PG8_WAIT_L(0); PG8_BAR; PG8_MMA(0, 0, At, B0); PG8_MMA(0, 1, At, B1); PG8_BAR; PG8_SCHED;
            PG8_LDA(At, 0, 1); PG8_STAGE(PG8_SB(0, 0), b2, voffB); PG8_STAGE(PG8_SB(0, 1), b2 + hstep, voffB); PG8_STAGE(PG8_SA(0, 0), a2, voffA);
            PG8_WAIT_V(8); PG8_WAIT_L(0); PG8_BAR; PG8_MMA(1, 0, At, B0); PG8_MMA(1, 1, At, B1); PG8_BAR; PG8_SCHED;
            PG8_LDB(B0, 1, 0); PG8_LDB(B1, 1, 1); PG8_SCHED; PG8_LDA(At, 1, 0); PG8_STAGE(PG8_SA(0, 1), a2 + hstep, voffA);
            PG8_WAIT_V(8); PG8_WAIT_L(0); PG8_BAR; PG8_MMA(0, 0, At, B0); PG8_MMA(0, 1, At, B1); PG8_BAR; PG8_SCHED;
            PG8_LDA(At, 1, 1); PG8_STAGE(PG8_SB(1, 0), b3, voffB); PG8_STAGE(PG8_SB(1, 1), b3 + hstep, voffB); PG8_STAGE(PG8_SA(1, 0), a3, voffA);
            PG8_WAIT_V(8); PG8_WAIT_L(0); PG8_BAR; PG8_MMA(1, 0, At, B0); PG8_MMA(1, 1, At, B1); PG8_BAR; PG8_SCHED;
            } else {
            PG8_LDB(B0, 0, 0); PG8_SCHED; PG8_LDA(At, 0, 0); PG8_STAGE(PG8_SA(1, 1), a1 + hstep, voffA);
            PG8_WAIT_L(8); PG8_BAR; PG8_WAIT_L(0); PG8_MMA(0, 0, At, B0); PG8_BAR; PG8_SCHED;
            PG8_LDB(B1, 0, 1); PG8_STAGE(PG8_SB(0, 0), b2, voffB);
            PG8_BAR; PG8_WAIT_L(0); PG8_MMA(0, 1, At, B1); PG8_BAR;
            PG8_LDA(At, 0, 1); PG8_STAGE(PG8_SA(0, 0), a2, voffA);
            PG8_BAR; PG8_WAIT_L(0); PG8_MMA(1, 0, At, B0); PG8_BAR; PG8_SCHED;
            PG8_STAGE(PG8_SB(0, 1), b2 + hstep, voffB);
            PG8_WAIT_V(6); PG8_BAR; PG8_MMA(1, 1, At, B1); PG8_BAR;
            PG8_LDB(B0, 1, 0); PG8_SCHED; PG8_LDA(At, 1, 0); PG8_STAGE(PG8_SA(0, 1), a2 + hstep, voffA);
            PG8_WAIT_L(8); PG8_BAR; PG8_WAIT_L(0); PG8_MMA(0, 0, At, B0); PG8_BAR; PG8_SCHED;
            PG8_LDB(B1, 1, 1); PG8_STAGE(PG8_SB(1, 0), b3, voffB);
            PG8_BAR; PG8_WAIT_L(0); PG8_MMA(0, 1, At, B1); PG8_BAR;
            PG8_LDA(At, 1, 1); PG8_STAGE(PG8_SA(1, 0), a3, voffA);
            PG8_BAR; PG8_WAIT_L(0); PG8_MMA(1, 0, At, B0); PG8_BAR; PG8_SCHED;
            PG8_STAGE(PG8_SB(1, 1), b3 + hstep, voffB);
            PG8_WAIT_V(6); PG8_BAR; PG8_MMA(1, 1, At, B1); PG8_BAR;
            }
        }
        if constexpr (ALIGN_EPI) { if (wr == 0) PG8_BAR; }
        if constexpr (!Epi::AFTER_DRAIN) { E(acc, cur, wr, wc, fr, fq); S.done(cur); }
        if (!has_next) break;
#pragma unroll
        for (int a = 0; a < 2; ++a)
#pragma unroll
            for (int b = 0; b < 2; ++b)
#pragma unroll
                for (int m = 0; m < 4; ++m)
#pragma unroll
                    for (int n = 0; n < 2; ++n) acc[a][b][m][n] = (f32x4){0.f, 0.f, 0.f, 0.f};
        cur = nxt; cA = nA; cB = nB; ++ui;
        if constexpr (ALIGN_EPI) { if (wr == 1) PG8_BAR; }
    }
    PG8_WAIT_V(0);
    if constexpr (!ALIGN_EPI) { if (wr == 0) PG8_BAR; }
    PG8_BAR;
    if constexpr (Epi::AFTER_DRAIN) { E.fused(acc, cur, wr, wc, fr, fq, lds, wid, lane); S.done(cur); }
#undef PG8_SA
#undef PG8_SB
#undef PG8_STAGE
#undef PG8_LDA
#undef PG8_LDB
#undef PG8_MMA
#undef PG8_WAIT_V
#undef PG8_WAIT_L
#undef PG8_BAR
#undef PG8_SCHED
}
}
#ifndef PG8_SP2
#define PG8_SP2 true
#endif
#ifndef PG8_ALIGN
#define PG8_ALIGN true
#endif
constexpr int NWAVES = 8;
constexpr int M = 16384, D = 2048, FF = 5632, INW = 5376, DEPTH = 2;
constexpr int OFF_QA = 0, OFF_KA = 1024, OFF_VA = 1152, OFF_QR = 1280, OFF_KR = 2304, OFF_VR = 3328, OFF_GR = 4352;
constexpr int NADA = 9 * D;
constexpr float NORM_EPS = 1e-6f, GN_EPS = 1e-5f;
#ifndef MK_PER_PHASE
#define MK_PER_PHASE 0
#endif
#ifndef SIMPLE_MIX
#define SIMPLE_MIX 0
#endif
constexpr int N_PHASES = 3 + 12 * DEPTH;

constexpr size_t MiB = 1u << 20;
constexpr size_t WS_CTL = 0, CTL_ZERO_BYTES = 1 * MiB;
constexpr size_t WS_MODP = 1 * MiB;
constexpr size_t WS_MODC = 4 * MiB;
constexpr size_t WS_W = 8 * MiB, W_LAYER = 161 * MiB;
constexpr size_t W_GU1 = 0, W_D1 = 44 * MiB, W_IN = 66 * MiB, W_OUT = 87 * MiB, W_GU2 = 95 * MiB, W_D2 = 139 * MiB;
constexpr size_t WS_H = 330 * MiB, WS_Y = 394 * MiB, WS_KV = 330 * MiB;
constexpr size_t WS_ACT = 458 * MiB;
constexpr size_t WS_MIX = 634 * MiB, WS_ST = 698 * MiB, WS_END = 762 * MiB;
static_assert(WS_W + 2 * W_LAYER <= WS_H && WS_ACT + (size_t)M * FF * 2 <= WS_MIX, "d_ws map");
constexpr int CW_BAR = 4096;
constexpr int RING_BYTES = 139264;
constexpr int LDSCTL_OFF = RING_BYTES, MISC_OFF = LDSCTL_OFF + 320;
constexpr int LDS_BYTES = 147456;

#define GAS __attribute__((address_space(1)))
#define LAS __attribute__((address_space(3)))
typedef unsigned short bf16;
typedef unsigned v4u __attribute__((ext_vector_type(4)));
typedef unsigned v2u __attribute__((ext_vector_type(2)));
typedef float f32x4 __attribute__((ext_vector_type(4)));
typedef float f32x2 __attribute__((ext_vector_type(2)));
typedef short bf16x8 __attribute__((ext_vector_type(8)));
typedef GAS unsigned gu32;
#define RLX_AGENT __ATOMIC_RELAXED, __HIP_MEMORY_SCOPE_AGENT
#define LDS_WAIT() asm volatile("s_waitcnt lgkmcnt(0)" ::: "memory")
#define VM_WAIT() asm volatile("s_waitcnt vmcnt(0)" ::: "memory")
__device__ __forceinline__ unsigned f2bf(float f) { unsigned u = __builtin_bit_cast(unsigned, f); return (u + 0x7fffu + ((u >> 16) & 1u)) >> 16; }
__device__ __forceinline__ unsigned pk2(float lo, float hi) { return f2bf(lo) | (f2bf(hi) << 16); }
__device__ __forceinline__ float bflo(unsigned u) { return __builtin_bit_cast(float, u << 16); }
__device__ __forceinline__ float bfhi(unsigned u) { return __builtin_bit_cast(float, u & 0xffff0000u); }
__device__ __forceinline__ float bf2f(bf16 b) { return __builtin_bit_cast(float, (unsigned)b << 16); }
__device__ __forceinline__ float wave_sum(float v) {
#pragma unroll
    for (int o = 1; o < 64; o <<= 1) v += __shfl_xor(v, o);
    return v;
}
__device__ __forceinline__ float wave_max(float v) {
#pragma unroll
    for (int o = 1; o < 64; o <<= 1) v = fmaxf(v, __shfl_xor(v, o));
    return v;
}
__device__ __forceinline__ float rdlane(float v, int l) { return __builtin_bit_cast(float, __builtin_amdgcn_readlane(__builtin_bit_cast(int, v), l)); }
__device__ __forceinline__ float silu_f(float g) { return g / (1.0f + __expf(-g)); }
__device__ __forceinline__ float lg2gamma(int hr) { return log2f(1.0f - exp2f(-5.0f - (float)hr)); }
#define XB_TMO      128
#define XB_XCNT(j)  (256  + 64 * (j))
#define XB_XSUB(j)  (1280 + 64 * (j))
#define XB_XGEN(j)  (2304 + 64 * (j))
#define XB_TOP      3328
#define XB_TOPGEN   3392
#define XCD_BAR_WORDS 3456
#define XB_SPIN_CAP (1u << 18)

__device__ __forceinline__ unsigned xb_ld(unsigned* p)              { return __hip_atomic_load(p, __ATOMIC_RELAXED, __HIP_MEMORY_SCOPE_AGENT); }
__device__ __forceinline__ unsigned xb_add(unsigned* p, unsigned v) { return __hip_atomic_fetch_add(p, v, __ATOMIC_RELAXED, __HIP_MEMORY_SCOPE_AGENT); }
__device__ __forceinline__ unsigned xb_xcc_id() { return (unsigned)__builtin_amdgcn_s_getreg((3 << 11) | 20) & 0xFu; }
#define XB_SPIN(cond, bar) do { unsigned _sp = 0; while (cond) { __builtin_amdgcn_s_sleep(1); \
    if ((++_sp & 255u) == 0u) { if (xb_ld(&(bar)[XB_TMO])) break; if (_sp > XB_SPIN_CAP) { atomicAdd(&(bar)[XB_TMO], 1u); break; } } } } while (0)

struct XcdBarrier {
    unsigned* bar; unsigned x;
    volatile LAS unsigned* st;
};

__device__ __forceinline__ XcdBarrier xcd_barrier_post(unsigned* bar, volatile LAS unsigned* st) {
    XcdBarrier b; b.bar = bar; b.x = xb_xcc_id(); b.st = st;
    if (threadIdx.x == 0) (void)xb_add(&bar[XB_XCNT(b.x)], 1u);
    return b;
}
__device__ __forceinline__ void xcd_barrier_complete(unsigned* bar, unsigned x, unsigned& nloc, unsigned& nx) {
    const unsigned G = gridDim.x * gridDim.y * gridDim.z;
    unsigned sum, cnt, mine, sp = 0u;
    for (;;) {
        sum = 0u; cnt = 0u; mine = 0u;
#pragma unroll
        for (unsigned j = 0; j < 16; ++j) { const unsigned c = xb_ld(&bar[XB_XCNT(j)]); sum += c; cnt += (c > 0u) ? 1u : 0u; mine = (j == x) ? c : mine; }
        if (sum == G) break;
        __builtin_amdgcn_s_sleep(1);
        if ((++sp & 255u) == 0u) { if (xb_ld(&bar[XB_TMO])) break; if (sp > XB_SPIN_CAP) { atomicAdd(&bar[XB_TMO], 1u); break; } }
    }
    nloc = mine > 0u ? mine : 1u; nx = cnt > 0u ? cnt : 1u;
}

__device__ __forceinline__ void xcd_barrier(const XcdBarrier& b) {
    asm volatile("s_waitcnt vmcnt(0)" ::: "memory");
    __syncthreads();
    if (threadIdx.x == 0) {
        unsigned* bar = b.bar; unsigned bx_ = b.x; asm volatile("" : "+s"(bx_));
        __builtin_amdgcn_s_waitcnt(0);
        unsigned nloc = b.st[0], nx = b.st[1];
        if (nloc == 0u) { xcd_barrier_complete(bar, bx_, nloc, nx); b.st[0] = nloc; b.st[1] = nx; }
        const unsigned old = xb_add(&bar[XB_XSUB(bx_)], 1u);
        const unsigned gen = old / nloc;
        if (old + 1u == (gen + 1u) * nloc) {
            __builtin_amdgcn_fence(__ATOMIC_RELEASE, "agent");
            asm volatile("s_waitcnt vmcnt(0)" ::: "memory");
            const unsigned og = xb_add(&bar[XB_TOP], 1u);
            const unsigned tg = og / nx;
            if (og + 1u == (tg + 1u) * nx) xb_add(&bar[XB_TOPGEN], 1u);
            else XB_SPIN(xb_ld(&bar[XB_TOPGEN]) == tg, bar);
            __builtin_amdgcn_fence(__ATOMIC_ACQUIRE, "agent");
            xb_add(&bar[XB_XGEN(bx_)], 1u);
            asm volatile("s_waitcnt vmcnt(0)" ::: "memory");
        } else {
            XB_SPIN(xb_ld(&bar[XB_XGEN(bx_)]) == gen, bar);
            __builtin_amdgcn_fence(__ATOMIC_ACQUIRE, "agent");
            asm volatile("s_waitcnt vmcnt(0)" ::: "memory");
        }
    }
    __syncthreads();
}
__device__ __forceinline__ void transpose_item(const float* W, int K, int N, bf16* WT, int k0, int n0, int dst_row0, LAS float* scr, int lane) {
    f32x4 v[16];
#pragma unroll
    for (int i = 0; i < 16; ++i) { const int kk = 4 * i + (lane >> 4); v[i] = *(const GAS f32x4*)(W + (size_t)(k0 + kk) * N + n0 + 4 * (lane & 15)); }
#pragma unroll
    for (int i = 0; i < 16; ++i) { const int kk = 4 * i + (lane >> 4); LAS float* d = scr + kk * 65 + 4 * (lane & 15); d[0] = v[i].x; d[1] = v[i].y; d[2] = v[i].z; d[3] = v[i].w; }
    LDS_WAIT(); asm volatile("" ::: "memory");
    const int c = lane & 7;
#pragma unroll
    for (int j = 0; j < 8; ++j) { const int n = (lane >> 3) + 8 * j; const LAS float* s = scr + (8 * c) * 65 + n;
        v4u o; o.x = pk2(s[0 * 65], s[1 * 65]); o.y = pk2(s[2 * 65], s[3 * 65]); o.z = pk2(s[4 * 65], s[5 * 65]); o.w = pk2(s[6 * 65], s[7 * 65]);
        *(GAS v4u*)(WT + (size_t)(dst_row0 + n) * K + k0 + 8 * c) = o; }
    LDS_WAIT(); asm volatile("" ::: "memory");
}
__device__ __forceinline__ void mods_partial_item(const float* cvec, const float* w_ada, float* modp, int item, int lane) {
    const int ks = item & 15, jb = (item >> 4) % 72, l = item / (16 * 72);
    const float c0 = cvec[ks * 128 + lane], c1 = cvec[ks * 128 + 64 + lane];
    const float a0 = silu_f(c0), a1 = silu_f(c1);
    const float* W = w_ada + ((size_t)l * D + ks * 128) * NADA + jb * 256 + 4 * lane;
    f32x4 acc = {0.f, 0.f, 0.f, 0.f};
#pragma unroll 16
    for (int kk = 0; kk < 64; ++kk) { const float s = rdlane(a0, kk); const f32x4 w = *(const GAS f32x4*)(W + (size_t)kk * NADA); acc += s * w; }
#pragma unroll 16
    for (int kk = 0; kk < 64; ++kk) { const float s = rdlane(a1, kk); const f32x4 w = *(const GAS f32x4*)(W + (size_t)(64 + kk) * NADA); acc += s * w; }
    *(GAS f32x4*)(modp + (size_t)ks * (2 * NADA) + l * NADA + jb * 256 + 4 * lane) = acc;
}
struct WSrc { const float *g1, *u1, *d1, *win, *wout, *g2, *u2, *d2; };
__device__ __forceinline__ void p_conv(LAS unsigned char* lds, const WSrc& S, const float* cvec, const float* w_ada, unsigned char* ws, int gw, int NGW, int wave, int lane) {
    LAS float* scr = (LAS float*)(lds + wave * 17408);
    for (int it = gw; it < 2 * 72 * 16; it += NGW) mods_partial_item(cvec, w_ada, (float*)(ws + WS_MODP), it, lane);
    constexpr int I_F = 32 * 88, I_IN = 32 * 84, I_OUT = 32 * 32, I_LAYER = 6 * I_F + I_IN + I_OUT;
    for (int it = gw; it < DEPTH * I_LAYER; it += NGW) {
        const int l = it / I_LAYER; int r = it % I_LAYER;
        unsigned char* wl = ws + WS_W + (size_t)l * W_LAYER;
        const float* W; bf16* WT; int K, N, mode = 0;
        if (r < I_F) { W = S.g1 + (size_t)l * D * FF; WT = (bf16*)(wl + W_GU1); K = D; N = FF; mode = 1; }
        else if ((r -= I_F) < I_F) { W = S.u1 + (size_t)l * D * FF; WT = (bf16*)(wl + W_GU1); K = D; N = FF; mode = 2; }
        else if ((r -= I_F) < I_F) { W = S.d1 + (size_t)l * D * FF; WT = (bf16*)(wl + W_D1); K = FF; N = D; }
        else if ((r -= I_F) < I_IN) { W = S.win + (size_t)l * D * INW; WT = (bf16*)(wl + W_IN); K = D; N = INW; }
        else if ((r -= I_IN) < I_OUT) { W = S.wout + (size_t)l * D * D; WT = (bf16*)(wl + W_OUT); K = D; N = D; }
        else if ((r -= I_OUT) < I_F) { W = S.g2 + (size_t)l * D * FF; WT = (bf16*)(wl + W_GU2); K = D; N = FF; mode = 1; }
        else if ((r -= I_F) < I_F) { W = S.u2 + (size_t)l * D * FF; WT = (bf16*)(wl + W_GU2); K = D; N = FF; mode = 2; }
        else { r -= I_F; W = S.d2 + (size_t)l * D * FF; WT = (bf16*)(wl + W_D2); K = FF; N = D; }
        const int nblk = N / 64, kb = r / nblk, nb = r % nblk, n0 = 64 * nb;
        const int drow = mode == 0 ? n0 : (256 * (n0 >> 7) + (n0 & 127) + (mode == 2 ? 128 : 0));
        transpose_item(W, K, N, WT, 64 * kb, n0, drow, scr, lane);
    }
}
__device__ __forceinline__ void p_fin(const float* modp, const float* b_ada, const float* npre, const float* npost, float* modc, int gtid, int nthr) {
    for (int i = gtid; i < DEPTH * 3 * D; i += nthr) {
        const int l = i / (3 * D), s = (i / D) % 3, c = i % D;
        float m[3];
#pragma unroll
        for (int t = 0; t < 3; ++t) { const int j = l * NADA + s * (3 * D) + t * D + c; float sum = b_ada[j];
#pragma unroll
            for (int ks = 0; ks < 16; ++ks) sum += modp[(size_t)ks * (2 * NADA) + j];
            m[t] = sum; }
        const float w = (s == 1) ? 1.0f : 0.5f;
        float* o = modc + (size_t)((l * 3 + s) * 3) * D + c;
        o[0] = npre[(l * 3 + s) * D + c] * (1.0f + m[1]); o[D] = m[0]; o[2 * D] = w * m[2] * npost[(l * 3 + s) * D + c];
    }
}
template <bool POST, bool PRE>
__device__ __forceinline__ void thin_phase(LAS unsigned char* lds, const float* xsrc, const bf16* y, float* xdst, bf16* h, const float* cA, const float* cB, const float* cP,
                                           int gw, int NGW, int tid, int lane) {
    LAS float* LA = (LAS float*)lds; LAS float* LB = LA + D; LAS float* LP = LB + D;
    for (int i = tid; i < D; i += NWAVES * 64) { if (PRE) { LA[i] = cA[i]; LB[i] = cB[i]; } if (POST) LP[i] = cP[i]; }
    __syncthreads();
    for (int r = gw; r < M; r += NGW) {
        f32x4 xv[4][2]; v4u yr[4];
        const float* xr = xsrc + (size_t)r * D + 8 * lane;
#pragma unroll
        for (int j = 0; j < 4; ++j) { xv[j][0] = *(const GAS f32x4*)(xr + 512 * j); xv[j][1] = *(const GAS f32x4*)(xr + 512 * j + 4); }
        if (POST) {
#pragma unroll
            for (int j = 0; j < 4; ++j) yr[j] = *(const GAS v4u*)(y + (size_t)r * D + 512 * j + 8 * lane);
            float ssq = 0.f; f32x4 yv[4][2];
#pragma unroll
            for (int j = 0; j < 4; ++j) { yv[j][0] = (f32x4){bflo(yr[j].x), bfhi(yr[j].x), bflo(yr[j].y), bfhi(yr[j].y)}; yv[j][1] = (f32x4){bflo(yr[j].z), bfhi(yr[j].z), bflo(yr[j].w), bfhi(yr[j].w)};
#pragma unroll
                for (int q = 0; q < 2; ++q) ssq += (yv[j][q].x * yv[j][q].x + yv[j][q].y * yv[j][q].y) + (yv[j][q].z * yv[j][q].z + yv[j][q].w * yv[j][q].w); }
            const float rstd = 1.0f / sqrtf(wave_sum(ssq) * (1.0f / D) + NORM_EPS);
            float* xo = xdst + (size_t)r * D + 8 * lane;
#pragma unroll
            for (int j = 0; j < 4; ++j)
#pragma unroll
                for (int q = 0; q < 2; ++q) { const f32x4 p = *(const LAS f32x4*)(LP + 512 * j + 8 * lane + 4 * q); xv[j][q] = xv[j][q] + p * yv[j][q] * rstd; *(GAS f32x4*)(xo + 512 * j + 4 * q) = xv[j][q]; }
        }
        if (PRE) {
            float ssq = 0.f;
#pragma unroll
            for (int j = 0; j < 4; ++j)
#pragma unroll
                for (int q = 0; q < 2; ++q) ssq += (xv[j][q].x * xv[j][q].x + xv[j][q].y * xv[j][q].y) + (xv[j][q].z * xv[j][q].z + xv[j][q].w * xv[j][q].w);
            const float rstd = 1.0f / sqrtf(wave_sum(ssq) * (1.0f / D) + NORM_EPS);
#pragma unroll
            for (int j = 0; j < 4; ++j) { f32x4 o[2];
#pragma unroll
                for (int q = 0; q < 2; ++q) { const f32x4 a = *(const LAS f32x4*)(LA + 512 * j + 8 * lane + 4 * q), b = *(const LAS f32x4*)(LB + 512 * j + 8 * lane + 4 * q); o[q] = xv[j][q] * rstd * a + b; }
                v4u w; w.x = pk2(o[0].x, o[0].y); w.y = pk2(o[0].z, o[0].w); w.z = pk2(o[1].x, o[1].y); w.w = pk2(o[1].z, o[1].w);
                *(GAS v4u*)(h + (size_t)r * D + 512 * j + 8 * lane) = w; }
        }
    }
    __syncthreads();
}
__device__ __forceinline__ void ret_scan(const float* kv, bf16* st, int gtid, int nthr) {
    for (int p = gtid; p < 4 * 32768; p += nthr) {
        const int hr = p >> 15, pp = p & 32767;
        const float decay = exp2f(128.0f * lg2gamma(hr));
        const float* kp = kv + (size_t)hr * 65536 + 2 * pp; bf16* sp = st + (size_t)hr * 65536 + 2 * pp;
        f32x2 s = {0.f, 0.f};
#pragma unroll 8
        for (int n = 0; n < 128; ++n) {
            *(GAS unsigned*)(sp + (size_t)n * 262144) = pk2(s.x, s.y);
            const f32x2 k = *(const GAS f32x2*)(kp + (size_t)n * 262144);
            s = s * decay + k;
        }
    }
}
#if 1
__device__ __forceinline__ void attn_simple(const bf16* proj, bf16* mix, const float* sinks, int gw, int NGW, int lane) {
    for (int it = gw; it < M * 16; it += NGW) {
        const int t = it >> 4, hq = it & 15, kh = hq >> 3;
        const float slope = exp2f(-0.5f * (float)(hq + 1)), sink = sinks[hq];
        const bf16* qp = proj + (size_t)t * INW + OFF_QA + hq * 64;
        float q[64];
#pragma unroll
        for (int c = 0; c < 8; ++c) { const v4u r = *(const GAS v4u*)(qp + 8 * c); q[8 * c + 0] = bflo(r.x); q[8 * c + 1] = bfhi(r.x); q[8 * c + 2] = bflo(r.y); q[8 * c + 3] = bfhi(r.y);
            q[8 * c + 4] = bflo(r.z); q[8 * c + 5] = bfhi(r.z); q[8 * c + 6] = bflo(r.w); q[8 * c + 7] = bfhi(r.w); }
        float sc[2];
#pragma unroll
        for (int kk = 0; kk < 2; ++kk) { const int s = t - 127 + lane + 64 * kk; float dot = 0.f;
            if (s >= 0) { const bf16* kp = proj + (size_t)s * INW + OFF_KA + kh * 64;
#pragma unroll
                for (int c = 0; c < 8; ++c) { const v4u r = *(const GAS v4u*)(kp + 8 * c);
                    dot += q[8 * c + 0] * bflo(r.x) + q[8 * c + 1] * bfhi(r.x) + q[8 * c + 2] * bflo(r.y) + q[8 * c + 3] * bfhi(r.y) + q[8 * c + 4] * bflo(r.z) + q[8 * c + 5] * bfhi(r.z) + q[8 * c + 6] * bflo(r.w) + q[8 * c + 7] * bfhi(r.w); } }
            const float dist = (float)(127 - lane - 64 * kk); sc[kk] = (s >= 0) ? dot * 0.125f - slope * dist : -INFINITY; }
        float m = wave_max(fmaxf(sc[0], sc[1])); m = fmaxf(m, sink);
        const float p0 = __expf(sc[0] - m), p1 = __expf(sc[1] - m);
        const float denom = wave_sum(p0 + p1) + __expf(sink - m);
        float o = 0.f;
        const bf16* vp = proj + OFF_VA + kh * 64 + lane;
        for (int j = 0; j < 64; ++j) { const int s = t - 127 + j; const float pj = rdlane(p0, j); if (s >= 0) o += pj * bf2f(vp[(size_t)s * INW]); }
        for (int j = 0; j < 64; ++j) { const int s = t - 63 + j; const float pj = rdlane(p1, j); if (s >= 0) o += pj * bf2f(vp[(size_t)s * INW]); }
        mix[(size_t)t * D + hq * 64 + lane] = (bf16)f2bf(o / denom);
    }
}
__device__ __forceinline__ void ret_kv_simple(const bf16* proj, float* kv, int n, int hr, int tid) {
    const int e4 = tid & 63, w = tid >> 6; const float lg = lg2gamma(hr);
    const bf16* Kb = proj + (size_t)(n * 128) * INW + OFF_KR + hr * 256; const bf16* Vb = proj + (size_t)(n * 128) * INW + OFF_VR + hr * 256 + 4 * e4;
    for (int dc = 0; dc < 4; ++dc) { const int d0 = 32 * w + 8 * dc; f32x4 acc[8];
#pragma unroll
        for (int dd = 0; dd < 8; ++dd) acc[dd] = (f32x4){0.f, 0.f, 0.f, 0.f};
        for (int j = 0; j < 128; ++j) { const float z = exp2f(lg * (float)(127 - j)) * 0.0625f;
            const v2u vr = *(const GAS v2u*)(Vb + (size_t)j * INW); const f32x4 v = {bflo(vr.x), bfhi(vr.x), bflo(vr.y), bfhi(vr.y)};
            const v4u kr = *(const GAS v4u*)(Kb + (size_t)j * INW + d0);
            const float k[8] = {bflo(kr.x) * z, bfhi(kr.x) * z, bflo(kr.y) * z, bfhi(kr.y) * z, bflo(kr.z) * z, bfhi(kr.z) * z, bflo(kr.w) * z, bfhi(kr.w) * z};
#pragma unroll
            for (int dd = 0; dd < 8; ++dd) acc[dd] += k[dd] * v; }
#pragma unroll
        for (int dd = 0; dd < 8; ++dd) *(GAS f32x4*)(kv + ((size_t)(n * 4 + hr) * 256 + d0 + dd) * 256 + 4 * e4) = acc[dd]; }
}
__device__ __forceinline__ void ret_out_simple(LAS unsigned char* lds, const bf16* proj, const bf16* state, bf16* mix, int n, int hr, int tid) {
    LAS float* S = (LAS float*)lds;
    const float lg = lg2gamma(hr);
    const bf16* Qb = proj + (size_t)(n * 128) * INW + OFF_QR + hr * 256; const bf16* Kb = proj + (size_t)(n * 128) * INW + OFF_KR + hr * 256;
    const bf16* Vb = proj + (size_t)(n * 128) * INW + OFF_VR + hr * 256; const bf16* Gb = proj + (size_t)(n * 128) * INW + OFF_GR + hr * 256;
    {
        const int i = tid >> 2, jq = tid & 3; float acc[32];
#pragma unroll
        for (int jj = 0; jj < 32; ++jj) acc[jj] = 0.f;
        for (int dc = 0; dc < 32; ++dc) { const v4u qr = *(const GAS v4u*)(Qb + (size_t)i * INW + 8 * dc);
            const float q0 = bflo(qr.x), q1 = bfhi(qr.x), q2 = bflo(qr.y), q3 = bfhi(qr.y), q4 = bflo(qr.z), q5 = bfhi(qr.z), q6 = bflo(qr.w), q7 = bfhi(qr.w);
#pragma unroll
            for (int jj = 0; jj < 32; ++jj) { const v4u kr = *(const GAS v4u*)(Kb + (size_t)(jq + 4 * jj) * INW + 8 * dc);
                acc[jj] += q0 * bflo(kr.x) + q1 * bfhi(kr.x) + q2 * bflo(kr.y) + q3 * bfhi(kr.y) + q4 * bflo(kr.z) + q5 * bfhi(kr.z) + q6 * bflo(kr.w) + q7 * bfhi(kr.w); } }
#pragma unroll
        for (int jj = 0; jj < 32; ++jj) { const int j = jq + 4 * jj; S[i * 129 + j] = (j <= i) ? acc[jj] * exp2f(lg * (float)(i - j)) * 0.0625f : 0.f; }
    }
    __syncthreads();
    {
        const int e4 = tid & 63, w = tid >> 6;
#pragma nounroll
        for (int hh = 0; hh < 2; ++hh) {
        int r0 = 16 * w + 8 * hh; asm volatile("" : "+v"(r0));
        f32x4 o[8];
#pragma unroll
        for (int ii = 0; ii < 8; ++ii) o[ii] = (f32x4){0.f, 0.f, 0.f, 0.f};
        if (n > 0) {
            const bf16* St = state + (size_t)(n * 4 + hr) * 65536 + 4 * e4;
            const bf16* Qr = Qb + (size_t)r0 * INW;
            for (int dc = 0; dc < 32; ++dc) { f32x4 sv[8];
#pragma unroll
                for (int dd = 0; dd < 8; ++dd) { const v2u r = *(const GAS v2u*)(St + (size_t)(8 * dc + dd) * 256); sv[dd] = (f32x4){bflo(r.x), bfhi(r.x), bflo(r.y), bfhi(r.y)}; }
#pragma unroll
                for (int ii = 0; ii < 8; ++ii) { const v4u qr = *(const GAS v4u*)(Qr + (size_t)ii * INW + 8 * dc);
                    o[ii] += bflo(qr.x) * sv[0] + bfhi(qr.x) * sv[1] + bflo(qr.y) * sv[2] + bfhi(qr.y) * sv[3] + bflo(qr.z) * sv[4] + bfhi(qr.z) * sv[5] + bflo(qr.w) * sv[6] + bfhi(qr.w) * sv[7]; } }
#pragma unroll
            for (int ii = 0; ii < 8; ++ii) o[ii] = o[ii] * exp2f(lg * (float)(r0 + ii + 1));
        }
        for (int j = 0; j < r0 + 8; ++j) { const v2u r = *(const GAS v2u*)(Vb + (size_t)j * INW + 4 * e4); const f32x4 v = {bflo(r.x), bfhi(r.x), bflo(r.y), bfhi(r.y)};
#pragma unroll
            for (int ii = 0; ii < 8; ++ii) o[ii] += S[(r0 + ii) * 129 + j] * v; }
#pragma unroll
        for (int ii = 0; ii < 8; ++ii) { const int i = r0 + ii;
            const float mu = wave_sum((o[ii].x + o[ii].y) + (o[ii].z + o[ii].w)) * (1.0f / 256.0f);
            const f32x4 dv = o[ii] - mu;
            const float var = wave_sum((dv.x * dv.x + dv.y * dv.y) + (dv.z * dv.z + dv.w * dv.w)) * (1.0f / 256.0f);
            const float rstd = 1.0f / sqrtf(var + GN_EPS);
            const v2u gr = *(const GAS v2u*)(Gb + (size_t)i * INW + 4 * e4);
            const f32x4 y = {silu_f(bflo(gr.x)) * dv.x * rstd, silu_f(bfhi(gr.x)) * dv.y * rstd, silu_f(bflo(gr.y)) * dv.z * rstd, silu_f(bfhi(gr.y)) * dv.w * rstd};
            v2u wv; wv.x = pk2(y.x, y.y); wv.y = pk2(y.z, y.w);
            *(GAS v2u*)(mix + (size_t)(n * 128 + i) * D + 1024 + hr * 256 + 4 * e4) = wv; }
        }
    }
    __syncthreads();
}
#endif
#ifndef MFMA_ATTN
#define MFMA_ATTN 1
#endif
#ifndef MFMA_RET
#define MFMA_RET 1
#endif
#if 1
typedef short s16x4 __attribute__((ext_vector_type(4)));
typedef short v4i16_t __attribute__((ext_vector_type(4)));
__device__ __forceinline__ s16x4 tr_read(const LAS unsigned char* p) { return __builtin_bit_cast(s16x4, __builtin_amdgcn_ds_read_tr16_b64_v4i16((LAS v4i16_t*)p)); }
__device__ __forceinline__ bf16x8 tr_frag(const LAS unsigned char* p, int second_off) { const s16x4 a = tr_read(p), b = tr_read(p + second_off); return (bf16x8){a.x, a.y, a.z, a.w, b.x, b.y, b.z, b.w}; }
__device__ __forceinline__ bf16x8 lds_frag(const LAS unsigned char* p) { return *(const LAS bf16x8*)p; }
__device__ __forceinline__ bf16x8 glb_frag(const bf16* p) { return *(const GAS bf16x8*)p; }
__device__ __forceinline__ bf16x8 pack_frag(const f32x4 a, const f32x4 b) { v4u w; w.x = pg8::cvt_pk_bf16(a[0], a[1]); w.y = pg8::cvt_pk_bf16(a[2], a[3]); w.z = pg8::cvt_pk_bf16(b[0], b[1]); w.w = pg8::cvt_pk_bf16(b[2], b[3]); return __builtin_bit_cast(bf16x8, w); }
#define MFMA16(a, b, c) __builtin_amdgcn_mfma_f32_16x16x32_bf16((a), (b), (c), 0, 0, 0)
constexpr int AT_STRIDE = 144, AT_V = 256 * AT_STRIDE;
constexpr int RT_STRIDE = 528, RT_B = 128 * RT_STRIDE;

__device__ __forceinline__ void attn_unit(LAS unsigned char* lds, const bf16* proj, bf16* mix, const float* sinks, int n, int kh, int tid) {
    const int lane = tid & 63, w = __builtin_amdgcn_readfirstlane(tid >> 6), fr = lane & 15, fq = lane >> 4;
#pragma unroll
    for (int i = 0; i < 4; ++i) { const int idx = tid + 512 * i, row = idx >> 3, ch = idx & 7, tok = (n - 1) * 128 + row;
        v4u k = {0u, 0u, 0u, 0u}, v = {0u, 0u, 0u, 0u};
        if (tok >= 0) { k = *(const GAS v4u*)(proj + (size_t)tok * INW + OFF_KA + kh * 64 + 8 * ch); v = *(const GAS v4u*)(proj + (size_t)tok * INW + OFF_VA + kh * 64 + 8 * ch); }
        *(LAS v4u*)(lds + row * AT_STRIDE + 16 * ch) = k; *(LAS v4u*)(lds + AT_V + row * AT_STRIDE + 16 * ch) = v; }
    __syncthreads();
    const int qt = w, t0 = 2 * (qt >> 1), qi = 16 * qt + fr;
    const bf16* qbase = proj + (size_t)(n * 128 + qi) * INW + OFF_QA + kh * 512 + 8 * fq;
    const LAS unsigned char* kbase = lds + (16 * t0 + fr) * AT_STRIDE + 16 * fq;
    const LAS unsigned char* vbase = lds + AT_V + (16 * t0 + 4 * fq + (fr >> 2)) * AT_STRIDE + 8 * (fr & 3);
    bf16x8 qn0 = glb_frag(qbase), qn1 = glb_frag(qbase + 32);
#pragma nounroll
    for (int g = 0; g < 8; ++g) {
        const int hq = kh * 8 + g;
        const bf16x8 q0 = qn0, q1 = qn1;
        if (g < 7) { qn0 = glb_frag(qbase + (g + 1) * 64); qn1 = glb_frag(qbase + (g + 1) * 64 + 32); }
        const float slope = __builtin_amdgcn_exp2f(-0.5f * (float)(hq + 1)), sink = sinks[hq];
        f32x4 s[10];
#pragma unroll
        for (int t = 0; t < 10; ++t) { const bf16x8 k0 = lds_frag(kbase + t * 16 * AT_STRIDE), k1 = lds_frag(kbase + t * 16 * AT_STRIDE + 64);
            s[t] = MFMA16(k0, q0, ((f32x4){0.f, 0.f, 0.f, 0.f})); s[t] = MFMA16(k1, q1, s[t]); }
        float mx = -INFINITY;
#pragma unroll
        for (int t = 0; t < 10; ++t)
#pragma unroll
            for (int r = 0; r < 4; ++r) { const int kj = 16 * (t0 + t) + 4 * fq + r, dist = qi + 128 - kj; const bool valid = dist >= 0 && dist < 128 && (n > 0 || kj >= 128);
                const float v = valid ? s[t][r] * 0.125f - slope * (float)dist : -INFINITY; s[t][r] = v; mx = fmaxf(mx, v); }
        mx = fmaxf(mx, __shfl_xor(mx, 16)); mx = fmaxf(mx, __shfl_xor(mx, 32));
        const float m = fmaxf(mx, sink); float sum = 0.f;
#pragma unroll
        for (int t = 0; t < 10; ++t)
#pragma unroll
            for (int r = 0; r < 4; ++r) { const float p = __expf(s[t][r] - m); s[t][r] = p; sum += p; }
        sum += __shfl_xor(sum, 16); sum += __shfl_xor(sum, 32);
        const float inv = 1.0f / (sum + __expf(sink - m));
        f32x4 o[4];
#pragma unroll
        for (int dt = 0; dt < 4; ++dt) o[dt] = (f32x4){0.f, 0.f, 0.f, 0.f};
#pragma unroll
        for (int sp = 0; sp < 5; ++sp) { const bf16x8 pf = pack_frag(s[2 * sp], s[2 * sp + 1]);
#pragma unroll
            for (int dt = 0; dt < 4; ++dt) { const bf16x8 vf = tr_frag(vbase + sp * 32 * AT_STRIDE + dt * 32, 16 * AT_STRIDE); o[dt] = MFMA16(vf, pf, o[dt]); } }
        bf16* op = mix + (size_t)(n * 128 + qi) * D + hq * 64 + 4 * fq;
#pragma unroll
        for (int dt = 0; dt < 4; ++dt) { v2u wv; wv.x = pg8::cvt_pk_bf16(o[dt][0] * inv, o[dt][1] * inv); wv.y = pg8::cvt_pk_bf16(o[dt][2] * inv, o[dt][3] * inv); *(GAS v2u*)(op + 16 * dt) = wv; }
    }
    __syncthreads();
}
__device__ __forceinline__ void ret_kv_unit(LAS unsigned char* lds, const bf16* proj, float* kvT, int n, int hr, int tid) {
    const int lane = tid & 63, w = __builtin_amdgcn_readfirstlane(tid >> 6), fr = lane & 15, fq = lane >> 4;
    const float lg = lg2gamma(hr);
#pragma unroll
    for (int i = 0; i < 8; ++i) { const int idx = tid + 512 * i, row = idx >> 5, ch = idx & 31;
        const v4u k = *(const GAS v4u*)(proj + (size_t)(n * 128 + row) * INW + OFF_KR + hr * 256 + 8 * ch); const v4u v = *(const GAS v4u*)(proj + (size_t)(n * 128 + row) * INW + OFF_VR + hr * 256 + 8 * ch);
        const float z = __builtin_amdgcn_exp2f(lg * (float)(127 - row));
        v4u ks; ks.x = pg8::cvt_pk_bf16(bflo(k.x) * z, bfhi(k.x) * z); ks.y = pg8::cvt_pk_bf16(bflo(k.y) * z, bfhi(k.y) * z); ks.z = pg8::cvt_pk_bf16(bflo(k.z) * z, bfhi(k.z) * z); ks.w = pg8::cvt_pk_bf16(bflo(k.w) * z, bfhi(k.w) * z);
        *(LAS v4u*)(lds + row * RT_STRIDE + 16 * ch) = ks; *(LAS v4u*)(lds + RT_B + row * RT_STRIDE + 16 * ch) = v; }
    __syncthreads();
    const int wd = w >> 1, we = w & 1;
    const LAS unsigned char* abase = lds + (8 * fq + (fr >> 2)) * RT_STRIDE + (64 * wd + 4 * (fr & 3)) * 2;
    float* obase = kvT + ((size_t)(n * 4 + hr) * 256 + fr) * 256 + 64 * wd + 4 * fq;
#pragma nounroll
    for (int eh = 0; eh < 2; ++eh) { const int e0 = 128 * we + 64 * eh;
        const LAS unsigned char* bbase = lds + RT_B + (8 * fq + (fr >> 2)) * RT_STRIDE + (e0 + 4 * (fr & 3)) * 2;
        f32x4 acc[4][4];
#pragma unroll
        for (int dt = 0; dt < 4; ++dt)
#pragma unroll
            for (int et = 0; et < 4; ++et) acc[dt][et] = (f32x4){0.f, 0.f, 0.f, 0.f};
#pragma unroll
        for (int s = 0; s < 4; ++s) { bf16x8 af[4], bfr[4];
#pragma unroll
            for (int dt = 0; dt < 4; ++dt) af[dt] = tr_frag(abase + s * 32 * RT_STRIDE + dt * 32, 4 * RT_STRIDE);
#pragma unroll
            for (int et = 0; et < 4; ++et) bfr[et] = tr_frag(bbase + s * 32 * RT_STRIDE + et * 32, 4 * RT_STRIDE);
#pragma unroll
            for (int dt = 0; dt < 4; ++dt)
#pragma unroll
                for (int et = 0; et < 4; ++et) acc[dt][et] = MFMA16(af[dt], bfr[et], acc[dt][et]); }
#pragma unroll
        for (int dt = 0; dt < 4; ++dt)
#pragma unroll
            for (int et = 0; et < 4; ++et) *(GAS f32x4*)(obase + (size_t)(e0 + 16 * et) * 256 + 16 * dt) = acc[dt][et] * 0.0625f; }
    __syncthreads();
}
__device__ __forceinline__ void ret_out_unit(LAS unsigned char* lds, const bf16* proj, const bf16* stT, bf16* mix, int n, int hr, int tid) {
    const int lane = tid & 63, w = __builtin_amdgcn_readfirstlane(tid >> 6), fr = lane & 15, fq = lane >> 4;
    const float lg = lg2gamma(hr);
    const int i_loc = 16 * w + fr;
    const bf16* qp = proj + (size_t)(n * 128 + i_loc) * INW + OFF_QR + hr * 256 + 8 * fq;
    bf16x8 qf[8];
#pragma unroll
    for (int ks = 0; ks < 8; ++ks) qf[ks] = glb_frag(qp + 32 * ks);
    f32x4 o[16];
#pragma unroll
    for (int et = 0; et < 16; ++et) o[et] = (f32x4){0.f, 0.f, 0.f, 0.f};
    if (n > 0) {
        const bf16* sp = stT + (size_t)(n * 4 + hr) * 65536;
#pragma unroll
        for (int i = 0; i < 16; ++i) { const int idx = tid + 512 * i, row = idx >> 5, ch = idx & 31; *(LAS v4u*)(lds + row * RT_STRIDE + 16 * ch) = *(const GAS v4u*)(sp + (size_t)row * 256 + 8 * ch); }
        __syncthreads();
        const LAS unsigned char* sb = lds + fr * RT_STRIDE + 16 * fq;
#pragma unroll
        for (int et = 0; et < 16; ++et)
#pragma unroll
            for (int ks = 0; ks < 8; ++ks) o[et] = MFMA16(lds_frag(sb + et * 16 * RT_STRIDE + ks * 64), qf[ks], o[et]);
        const float xi = __builtin_amdgcn_exp2f(lg * (float)(i_loc + 1));
#pragma unroll
        for (int et = 0; et < 16; ++et) o[et] = o[et] * xi;
        __syncthreads();
    }
#pragma unroll
    for (int i = 0; i < 8; ++i) { const int idx = tid + 512 * i, row = idx >> 5, ch = idx & 31;
        const v4u k = *(const GAS v4u*)(proj + (size_t)(n * 128 + row) * INW + OFF_KR + hr * 256 + 8 * ch); const v4u v = *(const GAS v4u*)(proj + (size_t)(n * 128 + row) * INW + OFF_VR + hr * 256 + 8 * ch);
        *(LAS v4u*)(lds + row * RT_STRIDE + 16 * ch) = k; *(LAS v4u*)(lds + RT_B + row * RT_STRIDE + 16 * ch) = v; }
    __syncthreads();
    f32x4 s[8];
    const LAS unsigned char* kb = lds + fr * RT_STRIDE + 16 * fq;
#pragma unroll
    for (int t = 0; t < 8; ++t) { s[t] = (f32x4){0.f, 0.f, 0.f, 0.f};
        if (t <= w) {
#pragma unroll
            for (int ks = 0; ks < 8; ++ks) s[t] = MFMA16(lds_frag(kb + t * 16 * RT_STRIDE + ks * 64), qf[ks], s[t]);
#pragma unroll
            for (int r = 0; r < 4; ++r) { const int j = 16 * t + 4 * fq + r; s[t][r] = (j <= i_loc) ? s[t][r] * __builtin_amdgcn_exp2f(lg * (float)(i_loc - j)) * 0.0625f : 0.f; } } }
    const LAS unsigned char* vb = lds + RT_B + (4 * fq + (fr >> 2)) * RT_STRIDE + 8 * (fr & 3);
#pragma unroll
    for (int sp = 0; sp < 4; ++sp) if (2 * sp <= w) { const bf16x8 pf = pack_frag(s[2 * sp], s[2 * sp + 1]);
#pragma unroll
        for (int et = 0; et < 16; ++et) o[et] = MFMA16(tr_frag(vb + sp * 32 * RT_STRIDE + et * 32, 16 * RT_STRIDE), pf, o[et]); }
    float sum = 0.f;
#pragma unroll
    for (int et = 0; et < 16; ++et) sum += (o[et][0] + o[et][1]) + (o[et][2] + o[et][3]);
    sum += __shfl_xor(sum, 16); sum += __shfl_xor(sum, 32);
    const float mu = sum * (1.0f / 256.0f); float var = 0.f;
#pragma unroll
    for (int et = 0; et < 16; ++et) { o[et] = o[et] - mu; var += (o[et][0] * o[et][0] + o[et][1] * o[et][1]) + (o[et][2] * o[et][2] + o[et][3] * o[et][3]); }
    var += __shfl_xor(var, 16); var += __shfl_xor(var, 32);
    const float rstd = 1.0f / sqrtf(var * (1.0f / 256.0f) + GN_EPS);
    const bf16* gp = proj + (size_t)(n * 128 + i_loc) * INW + OFF_GR + hr * 256 + 4 * fq;
    bf16* op = mix + (size_t)(n * 128 + i_loc) * D + 1024 + hr * 256 + 4 * fq;
#pragma unroll
    for (int et = 0; et < 16; ++et) { const v2u gr = *(const GAS v2u*)(gp + 16 * et);
        v2u wv; wv.x = pg8::cvt_pk_bf16(silu_f(bflo(gr.x)) * o[et][0] * rstd, silu_f(bfhi(gr.x)) * o[et][1] * rstd); wv.y = pg8::cvt_pk_bf16(silu_f(bflo(gr.y)) * o[et][2] * rstd, silu_f(bfhi(gr.y)) * o[et][3] * rstd);
        *(GAS v2u*)(op + 16 * et) = wv; }
    __syncthreads();
}
#endif
struct Args { const float* in[15]; float* out; unsigned char* ws; int ph_lo, ph_hi, li, pad; };
__global__ void __launch_bounds__(NWAVES * 64, 2) mega_fwd(Args args) {
    extern __shared__ __attribute__((aligned(16))) unsigned char lds_raw[];
    LAS unsigned char* lds = (LAS unsigned char*)lds_raw;
    volatile LAS unsigned* MISC = (volatile LAS unsigned*)(lds + MISC_OFF);
    const int tid = threadIdx.x, lane = tid & 63, wave = __builtin_amdgcn_readfirstlane(tid >> 6);
    const int G = gridDim.x, bx = blockIdx.x, vcu = (G % 8 == 0) ? (bx % 8) * (G / 8) + bx / 8 : bx;
    const int gw = vcu * NWAVES + wave, NGW = G * NWAVES, gtid = vcu * (NWAVES * 64) + tid, nthr = G * NWAVES * 64;
    typedef const __attribute__((address_space(4))) Args* KArgs;
    KArgs ka0 = (KArgs)__builtin_amdgcn_kernarg_segment_ptr();
    gu32* ctl = (gu32*)(ka0->ws + WS_CTL);
    for (int u = tid; u < (LDS_BYTES - LDSCTL_OFF) / 4; u += NWAVES * 64) ((LAS unsigned*)(lds + LDSCTL_OFF))[u] = 0u;
    __syncthreads();
    XcdBarrier bar; bar.bar = (unsigned*)(ctl + CW_BAR) + ka0->li * XCD_BAR_WORDS; bar.x = 0; bar.st = nullptr;
    const int lo = ka0->ph_lo, hi = ka0->ph_hi;
    if (hi - lo > 1) bar = xcd_barrier_post((unsigned*)(ctl + CW_BAR) + ka0->li * XCD_BAR_WORDS, MISC + 8);
#define IN(k) (lo <= (k) && (k) < hi)
#define SEAM(k) do { if (IN((k) + 1)) xcd_barrier(bar); } while (0)
#define OPQ(p) asm volatile("" : "+s"(p))
#define PHASE_PTRS KArgs ka = (KArgs)__builtin_amdgcn_kernarg_segment_ptr(); OPQ(ka); unsigned char* w = ka->ws; float* out = ka->out; int tid_ = threadIdx.x; asm volatile("" : "+v"(tid_)); const int lane_ = tid_ & 63; int vcu_ = vcu; OPQ(vcu_); int Gp = G; OPQ(Gp); int bxp = bx; OPQ(bxp); const int wv_ = __builtin_amdgcn_readfirstlane(tid_ >> 6); const int gw_ = vcu_ * NWAVES + wv_; const int NGWp = Gp * NWAVES; const int nthr_ = Gp * NWAVES * 64; const int gtid_ = vcu_ * (NWAVES * 64) + tid_; (void)NGWp; (void)nthr_; (void)bxp; (void)lane_; (void)gw_; (void)gtid_; \
    bf16* Hb = (bf16*)(w + WS_H); bf16* Yb = (bf16*)(w + WS_Y); bf16* ACT = (bf16*)(w + WS_ACT); bf16* PROJ = (bf16*)(w + WS_ACT); bf16* MIX = (bf16*)(w + WS_MIX); \
    float* KV = (float*)(w + WS_KV); bf16* ST = (bf16*)(w + WS_ST); float* modp = (float*)(w + WS_MODP); float* modc = (float*)(w + WS_MODC); \
    (void)out; (void)Hb; (void)Yb; (void)ACT; (void)PROJ; (void)MIX; (void)KV; (void)ST; (void)modp; (void)modc;

    if (IN(0)) { PHASE_PTRS WSrc S{ka->in[6], ka->in[7], ka->in[8], ka->in[9], ka->in[10], ka->in[12], ka->in[13], ka->in[14]};
        p_conv(lds, S, ka->in[1], ka->in[2], w, gw_, NGWp, wv_, lane_); SEAM(0); }
    if (IN(1)) { PHASE_PTRS p_fin(modp, ka->in[3], ka->in[4], ka->in[5], modc, gtid_, nthr_); SEAM(1); }
    if (IN(2)) { PHASE_PTRS thin_phase<false, true>(lds, ka->in[0], nullptr, nullptr, Hb, modc, modc + D, nullptr, gw_, NGWp, tid_, lane_); SEAM(2); }
#pragma nounroll
    for (int l = 0; l < DEPTH; ++l) {
        const int pb = 3 + 12 * l;
#define LAYER_PTRS PHASE_PTRS unsigned char* wl = w + WS_W + (size_t)l * W_LAYER; const float* mc = modc + (size_t)l * 9 * D; (void)wl; (void)mc;
        if (IN(pb + 0)) { LAYER_PTRS pg8::Gemm g{Hb, (const bf16*)(wl + W_GU1), M, 2 * FF, D}; pg8::StaticOrder S; S.init(M, 2 * FF, Gp, bxp);
            pg8::EpiSwiGLU E{ACT, FF}; pg8::gemm_phase<pg8::EpiSwiGLU, pg8::StaticOrder, PG8_ALIGN, PG8_SP2>(lds, g, S, E, tid_); SEAM(pb + 0); }
        if (IN(pb + 1)) { LAYER_PTRS pg8::Gemm g{ACT, (const bf16*)(wl + W_D1), M, D, FF}; pg8::StaticOrder S; S.init(M, D, Gp, bxp);
            pg8::EpiBf16 E{Yb, D}; pg8::gemm_phase<pg8::EpiBf16, pg8::StaticOrder, PG8_ALIGN, PG8_SP2>(lds, g, S, E, tid_); SEAM(pb + 1); }
        if (IN(pb + 2)) { LAYER_PTRS const float* xs = l == 0 ? ka->in[0] : out; thin_phase<true, true>(lds, xs, Yb, out, Hb, mc + 3 * D, mc + 4 * D, mc + 2 * D, gw_, NGWp, tid_, lane_); SEAM(pb + 2); }
        if (IN(pb + 3)) { LAYER_PTRS pg8::Gemm g{Hb, (const bf16*)(wl + W_IN), M, INW, D}; pg8::StaticOrder S; S.init(M, INW, Gp, bxp);
            pg8::EpiBf16 E{PROJ, INW}; pg8::gemm_phase<pg8::EpiBf16, pg8::StaticOrder, PG8_ALIGN, PG8_SP2>(lds, g, S, E, tid_); SEAM(pb + 3); }
        if (IN(pb + 4)) { LAYER_PTRS
#if MFMA_ATTN
            for (int u = vcu_; u < 256; u += Gp) attn_unit(lds, PROJ, MIX, ka->in[11] + l * 16, u >> 1, u & 1, tid_);
#else
            attn_simple(PROJ, MIX, ka->in[11] + l * 16, gw_, NGWp, lane_);
#endif
#if MFMA_RET
            for (int u = vcu_; u < 512; u += Gp) ret_kv_unit(lds, PROJ, KV, u >> 2, u & 3, tid_);
#else
            for (int u = vcu_; u < 512; u += Gp) ret_kv_simple(PROJ, KV, u >> 2, u & 3, tid_);
#endif
            SEAM(pb + 4); }
        if (IN(pb + 5)) { LAYER_PTRS ret_scan(KV, ST, gtid_, nthr_); SEAM(pb + 5); }
        if (IN(pb + 6)) { LAYER_PTRS
#if MFMA_RET
            for (int u = vcu_; u < 512; u += Gp) ret_out_unit(lds, PROJ, ST, MIX, u >> 2, u & 3, tid_);
#else
            for (int u = vcu_; u < 512; u += Gp) ret_out_simple(lds, PROJ, ST, MIX, u >> 2, u & 3, tid_);
#endif
            SEAM(pb + 6); }
        if (IN(pb + 7)) { LAYER_PTRS pg8::Gemm g{MIX, (const bf16*)(wl + W_OUT), M, D, D}; pg8::StaticOrder S; S.init(M, D, Gp, bxp);
            pg8::EpiBf16 E{Yb, D}; pg8::gemm_phase<pg8::EpiBf16, pg8::StaticOrder, PG8_ALIGN, PG8_SP2>(lds, g, S, E, tid_); SEAM(pb + 7); }
        if (IN(pb + 8)) { LAYER_PTRS thin_phase<true, true>(lds, out, Yb, out, Hb, mc + 6 * D, mc + 7 * D, mc + 5 * D, gw_, NGWp, tid_, lane_); SEAM(pb + 8); }
        if (IN(pb + 9)) { LAYER_PTRS pg8::Gemm g{Hb, (const bf16*)(wl + W_GU2), M, 2 * FF, D}; pg8::StaticOrder S; S.init(M, 2 * FF, Gp, bxp);
            pg8::EpiSwiGLU E{ACT, FF}; pg8::gemm_phase<pg8::EpiSwiGLU, pg8::StaticOrder, PG8_ALIGN, PG8_SP2>(lds, g, S, E, tid_); SEAM(pb + 9); }
        if (IN(pb + 10)) { LAYER_PTRS pg8::Gemm g{ACT, (const bf16*)(wl + W_D2), M, D, FF}; pg8::StaticOrder S; S.init(M, D, Gp, bxp);
            pg8::EpiBf16 E{Yb, D}; pg8::gemm_phase<pg8::EpiBf16, pg8::StaticOrder, PG8_ALIGN, PG8_SP2>(lds, g, S, E, tid_); SEAM(pb + 10); }
        if (IN(pb + 11)) { LAYER_PTRS
            if (l + 1 < DEPTH) thin_phase<true, true>(lds, out, Yb, out, Hb, mc + 9 * D, mc + 10 * D, mc + 8 * D, gw_, NGWp, tid_, lane_);
            else thin_phase<true, false>(lds, out, Yb, out, nullptr, nullptr, nullptr, mc + 8 * D, gw_, NGWp, tid_, lane_);
            SEAM(pb + 11); }
    }
#undef IN
#undef SEAM
}

extern "C" void kernel_launch(void* const* d_in, const int* in_sizes, int n_in, void* d_out, int out_size, void* d_ws, size_t ws_size, hipStream_t stream) {
    static int grid = 0;
    if (grid == 0) {
        if (n_in != 15 || in_sizes[0] != M * D || out_size != M * D || ws_size < WS_END) { fprintf(stderr, "kernel_launch: shape/workspace mismatch (n_in %d, in0 %d, out %d, ws %zu)\n", n_in, n_in > 0 ? in_sizes[0] : -1, out_size, ws_size); grid = -1; return; }
        int dev = 0, cus = 0, per_cu = 0;
        if (hipGetDevice(&dev) != hipSuccess || hipDeviceGetAttribute(&cus, hipDeviceAttributeMultiprocessorCount, dev) != hipSuccess) { grid = -1; return; }
        if (hipFuncSetAttribute((const void*)mega_fwd, hipFuncAttributeMaxDynamicSharedMemorySize, LDS_BYTES) != hipSuccess) { fprintf(stderr, "kernel_launch: hipFuncSetAttribute failed\n"); grid = -1; return; }
        if (hipOccupancyMaxActiveBlocksPerMultiprocessor(&per_cu, (const void*)mega_fwd, NWAVES * 64, LDS_BYTES) != hipSuccess || per_cu < 1) fprintf(stderr, "kernel_launch: occupancy query says %d\n", per_cu);
        (void)hipGetLastError();
        grid = cus;
    }
    if (grid < 0) return;
    if (hipMemsetAsync((char*)d_ws + WS_CTL, 0, CTL_ZERO_BYTES, stream) != hipSuccess) return;
    Args a{};
    for (int i = 0; i < 15; ++i) a.in[i] = (const float*)d_in[i];
    a.out = (float*)d_out; a.ws = (unsigned char*)d_ws;
#if MK_PER_PHASE
    for (int p = 0; p < N_PHASES; ++p) { a.ph_lo = p; a.ph_hi = p + 1; a.li = 0; hipLaunchKernelGGL(mega_fwd, dim3(grid), dim3(NWAVES * 64), LDS_BYTES, stream, a); }
#else
    a.ph_lo = 0; a.ph_hi = N_PHASES; a.li = 0;
    hipLaunchKernelGGL(mega_fwd, dim3(grid), dim3(NWAVES * 64), LDS_BYTES, stream, a);
#endif
    const hipError_t le = hipPeekAtLastError();
    if (le != hipSuccess) fprintf(stderr, "kernel_launch: launch failed: %s\n", hipGetErrorName(le));
}
```
